# Optimizing an MI355X kernel written in HIP

```python
import math
import jax, jax.numpy as jnp
from jax import lax
import numpy as np

D_MODEL = 2048
BATCH = 8
SEQ = 2048
DEPTH = 1

N_ATT_HEADS = D_MODEL // 256
QK_NOPE_DIM = 128
QK_ROPE_DIM = 64
QK_HEAD_DIM = QK_NOPE_DIM + QK_ROPE_DIM
V_HEAD_DIM = 128
Q_LORA_RANK = D_MODEL // 4
KV_LORA_RANK = D_MODEL // 8
ATT_WIDTH = N_ATT_HEADS * V_HEAD_DIM
ATT_Q_BLOCK = 128
ROPE_THETA = 10000.0
N_REC_HEADS = D_MODEL // 256
REC_KEY_DIM = 128
REC_VAL_DIM = 128
REC_QK = N_REC_HEADS * REC_KEY_DIM
REC_WIDTH = N_REC_HEADS * REC_VAL_DIM
REC_CHUNK = 64
MIX_WIDTH = ATT_WIDTH + REC_WIDTH
IN_COLS = Q_LORA_RANK + KV_LORA_RANK + QK_ROPE_DIM + 3 * REC_QK + 2 * REC_WIDTH
IN_SPLITS = (
    Q_LORA_RANK,
    Q_LORA_RANK + KV_LORA_RANK,
    Q_LORA_RANK + KV_LORA_RANK + QK_ROPE_DIM,
    Q_LORA_RANK + KV_LORA_RANK + QK_ROPE_DIM + REC_QK,
    Q_LORA_RANK + KV_LORA_RANK + QK_ROPE_DIM + 2 * REC_QK,
    Q_LORA_RANK + KV_LORA_RANK + QK_ROPE_DIM + 3 * REC_QK,
    Q_LORA_RANK + KV_LORA_RANK + QK_ROPE_DIM + 3 * REC_QK + REC_WIDTH,
)
N_EXPERTS = 64
TOP_K = 8
N_GROUPS = 8
TOPK_GROUPS = 4
EXPERT_DIM = 512
SHARED_DIM = 512
ROUTED_SCALE = 2.5
MOE_BLOCK = 256
EPS = 1e-6

kernel_name = "hymba_mla_hgrn2_moe_adaln_encoder"


def rms_norm(x, w):
    xf = x.astype(jnp.float32)
    y = xf * lax.rsqrt(jnp.mean(xf * xf, axis=-1, keepdims=True) + EPS)
    return (y * w.astype(jnp.float32)).astype(x.dtype)


def swiglu(x, w_gate, w_up, w_down):
    return (jax.nn.silu(x @ w_gate) * (x @ w_up)) @ w_down


def rope_tables(positions, dtype):
    inv_freq = ROPE_THETA ** (-jnp.arange(0, QK_ROPE_DIM, 2, dtype=jnp.float32) / QK_ROPE_DIM)
    ang = positions.astype(jnp.float32)[..., None] * inv_freq
    return jnp.cos(ang)[:, :, None, :].astype(dtype), jnp.sin(ang)[:, :, None, :].astype(dtype)


def apply_rope(t, cos, sin):
    t1, t2 = jnp.split(t, 2, axis=-1)
    return jnp.concatenate([t1 * cos - t2 * sin, t1 * sin + t2 * cos], axis=-1)


def mla_attention(q_lat, kv_lat, k_rope, cos, sin, q_lat_norm_w, w_uq, kv_lat_norm_w, w_ukv,
                  q_norm_w, k_norm_w):
    B, S, _ = q_lat.shape
    H = N_ATT_HEADS
    q = (rms_norm(q_lat, q_lat_norm_w) @ w_uq).reshape(B, S, H, QK_HEAD_DIM)
    kv = (rms_norm(kv_lat, kv_lat_norm_w) @ w_ukv).reshape(B, S, H, QK_NOPE_DIM + V_HEAD_DIM)
    k_nope, v = kv[..., :QK_NOPE_DIM], kv[..., QK_NOPE_DIM:]
    k = jnp.concatenate([k_nope, jnp.broadcast_to(k_rope[:, :, None, :], (B, S, H, QK_ROPE_DIM))], -1)
    q = rms_norm(q, q_norm_w)
    k = rms_norm(k, k_norm_w)

    def rope_part(t):
        return jnp.concatenate([t[..., :QK_NOPE_DIM], apply_rope(t[..., QK_NOPE_DIM:], cos, sin)], -1)

    q = rope_part(q).transpose(0, 2, 1, 3)
    k = rope_part(k).transpose(0, 2, 1, 3)
    v = v.transpose(0, 2, 1, 3)
    nq = S // ATT_Q_BLOCK
    q_blocks = q.reshape(B, H, nq, ATT_Q_BLOCK, QK_HEAD_DIM).transpose(2, 0, 1, 3, 4)
    scale = QK_HEAD_DIM ** -0.5

    def attend(qb):
        s = jnp.einsum('bhqd,bhkd->bhqk', qb, k).astype(jnp.float32) * scale
        p = jax.nn.softmax(s, axis=-1)
        return jnp.einsum('bhqk,bhkd->bhqd', p.astype(v.dtype), v)

    o = lax.map(attend, q_blocks)
    return o.transpose(1, 0, 3, 2, 4).reshape(B, S, H * V_HEAD_DIM)


def hgrn2_chunk_scan(q, k, v, log_f):
    B, H, S, K = q.shape
    V = v.shape[-1]
    C = REC_CHUNK
    n = S // C

    def to_chunks(a):
        return a.reshape(B, H, n, C, a.shape[-1]).transpose(2, 0, 1, 3, 4)

    qc, kc, vc, gc = to_chunks(q), to_chunks(k), to_chunks(v), to_chunks(log_f)
    mask = jnp.tril(jnp.ones((C, C), dtype=bool))

    def step(state, inp):
        q_, k_, v_, g_ = inp
        q_ = q_.astype(jnp.float32)
        k_ = k_.astype(jnp.float32)
        v_ = v_.astype(jnp.float32)
        b = jnp.cumsum(g_.astype(jnp.float32), axis=2)
        diff = b[:, :, :, None, :] - b[:, :, None, :, :]
        decay = jnp.exp(jnp.where(mask[:, :, None], diff, -jnp.inf))
        a = jnp.einsum('bhtsk,bhsk->bhts', q_[:, :, :, None, :] * decay, k_)
        o_intra = jnp.einsum('bhts,bhsv->bhtv', a, v_)
        o_inter = jnp.einsum('bhtk,bhkv->bhtv', q_ * jnp.exp(b), state)
        b_last = b[:, :, -1:, :]
        k_dec = k_ * jnp.exp(b_last - b)
        new_state = state * jnp.exp(b_last)[:, :, 0, :, None] + jnp.einsum('bhsk,bhsv->bhkv', k_dec, v_)
        return new_state, o_intra + o_inter

    state0 = jnp.zeros((B, H, K, V), jnp.float32)
    _, o = lax.scan(step, state0, (qc, kc, vc, gc))
    return o.transpose(1, 2, 0, 3, 4).reshape(B, H, S, V)


def hgrn2_mixer(r_q, r_ff, r_fb, r_i, r_g, lb_f, lb_b, rec_norm_w):
    B, S, _ = r_q.shape
    H = N_REC_HEADS

    def heads(a, d):
        return a.reshape(B, S, H, d).transpose(0, 2, 1, 3)

    q = heads(r_q, REC_KEY_DIM)
    v = heads(r_i, REC_VAL_DIM)

    def gate(z, lb):
        f = lb + (1.0 - lb) * jax.nn.sigmoid(z.astype(jnp.float32))
        return heads(jnp.log(f), REC_KEY_DIM), heads(1.0 - f, REC_KEY_DIM)

    logf_f, k_f = gate(r_ff, lb_f)
    logf_b, k_b = gate(r_fb, lb_b)
    o_f = hgrn2_chunk_scan(q, k_f, v, logf_f)

    def flip(a):
        return jnp.flip(a, axis=2)

    o_b = flip(hgrn2_chunk_scan(flip(q), flip(k_b), flip(v), flip(logf_b)))
    o = (o_f + o_b).transpose(0, 2, 1, 3)
    o = rms_norm(o, rec_norm_w).astype(r_i.dtype) * jax.nn.silu(r_g.reshape(B, S, H, REC_VAL_DIM))
    return o.reshape(B, S, H * REC_VAL_DIM)


def moe_ffn(h, w_router, router_bias, w_gate, w_up, w_down, ws_gate, ws_up, ws_down):
    B, S, D = h.shape
    T = B * S
    E = N_EXPERTS
    xt = h.reshape(T, D)
    scores = jax.nn.sigmoid((xt @ w_router).astype(jnp.float32))
    sel = scores + router_bias.astype(jnp.float32)
    grp_score = lax.top_k(sel.reshape(T, N_GROUPS, E // N_GROUPS), 2)[0].sum(-1)
    _, grp_idx = lax.top_k(grp_score, TOPK_GROUPS)
    grp_mask = jnp.any(grp_idx[:, :, None] == jnp.arange(N_GROUPS)[None, None, :], axis=1)
    sel = jnp.where(jnp.repeat(grp_mask, E // N_GROUPS, axis=-1), sel, -jnp.inf)
    _, top_idx = lax.top_k(sel, TOP_K)
    top_w = jnp.take_along_axis(scores, top_idx, axis=-1)
    top_w = top_w / jnp.sum(top_w, axis=-1, keepdims=True) * ROUTED_SCALE

    A = T * TOP_K
    flat_e = top_idx.reshape(A).astype(jnp.int32)
    flat_tok = jnp.repeat(jnp.arange(T, dtype=jnp.int32), TOP_K)
    flat_w = top_w.reshape(A)
    order = jnp.argsort(flat_e)
    se, st, sw = flat_e[order], flat_tok[order], flat_w[order]
    counts = jnp.bincount(flat_e, length=E).astype(jnp.int32)
    padded = (counts + MOE_BLOCK - 1) // MOE_BLOCK * MOE_BLOCK
    pad_end = jnp.cumsum(padded)
    pad_start = pad_end - padded
    grp_start = jnp.cumsum(counts) - counts
    dest = pad_start[se] + jnp.arange(A, dtype=jnp.int32) - grp_start[se]
    n_blocks = -(-A // MOE_BLOCK) + E
    P = n_blocks * MOE_BLOCK
    buf_tok = jnp.full((P,), T, jnp.int32).at[dest].set(st)
    buf_w = jnp.zeros((P,), jnp.float32).at[dest].set(sw)
    blk_expert = jnp.minimum(
        jnp.searchsorted(pad_end, jnp.arange(n_blocks, dtype=jnp.int32) * MOE_BLOCK, side='right'),
        E - 1).astype(jnp.int32)
    xt_pad = jnp.concatenate([xt, jnp.zeros((1, D), xt.dtype)], axis=0)

    def body(acc, inp):
        tok, wgt, e = inp
        xb = xt_pad[tok]
        yb = swiglu(xb, w_gate[e], w_up[e], w_down[e]).astype(jnp.float32) * wgt[:, None]
        return acc.at[tok].add(yb), None

    acc0 = jnp.zeros((T + 1, D), jnp.float32)
    routed, _ = lax.scan(body, acc0, (buf_tok.reshape(n_blocks, MOE_BLOCK),
                                      buf_w.reshape(n_blocks, MOE_BLOCK), blk_expert))
    y = routed[:T].astype(xt.dtype) + swiglu(xt, ws_gate, ws_up, ws_down)
    return y.reshape(B, S, D)


def setup_inputs(seed: int = 0) -> dict:
    key = jax.random.key(seed)
    ks = iter(jax.random.split(key, 32))
    L, D, H = DEPTH, D_MODEL, N_ATT_HEADS

    def nrm(shape, fan_in, scale=1.0):
        return jax.random.normal(next(ks), shape, jnp.float32) * (scale * fan_in ** -0.5)

    def gain(shape):
        return 1.0 + 0.02 * jax.random.normal(next(ks), shape, jnp.float32)

    x = jax.random.normal(next(ks), (BATCH, SEQ, D), jnp.float32)
    c = jax.random.normal(next(ks), (BATCH, D), jnp.float32)
    positions = (jnp.arange(SEQ, dtype=jnp.int32)[None, :]
                 + jax.random.randint(next(ks), (BATCH, 1), 0, 512, dtype=jnp.int32))
    return {
        "x": x,
        "c": c,
        "positions": positions,
        "w_ada": nrm((L, D, 6 * D), D, 0.5),
        "b_ada": 0.02 * jax.random.normal(next(ks), (L, 6 * D), jnp.float32),
        "norm1_w": gain((L, D)),
        "w_in": nrm((L, D, IN_COLS), D),
        "q_lat_norm_w": gain((L, Q_LORA_RANK)),
        "w_uq": nrm((L, Q_LORA_RANK, H * QK_HEAD_DIM), Q_LORA_RANK),
        "kv_lat_norm_w": gain((L, KV_LORA_RANK)),
        "w_ukv": nrm((L, KV_LORA_RANK, H * (QK_NOPE_DIM + V_HEAD_DIM)), KV_LORA_RANK),
        "q_norm_w": gain((L, QK_HEAD_DIM)),
        "k_norm_w": gain((L, QK_HEAD_DIM)),
        "lb_fwd": 0.5 * jax.random.normal(next(ks), (L + 1, REC_QK), jnp.float32),
        "lb_bwd": 0.5 * jax.random.normal(next(ks), (L + 1, REC_QK), jnp.float32),
        "rec_norm_w": gain((L, REC_VAL_DIM)),
        "w_out": nrm((L, MIX_WIDTH, D), MIX_WIDTH),
        "norm2_w": gain((L, D)),
        "w_router": nrm((L, D, N_EXPERTS), D),
        "router_bias": 0.01 * jax.random.normal(next(ks), (L, N_EXPERTS), jnp.float32),
        "w_exp_gate": nrm((L, N_EXPERTS, D, EXPERT_DIM), D),
        "w_exp_up": nrm((L, N_EXPERTS, D, EXPERT_DIM), D),
        "w_exp_down": nrm((L, N_EXPERTS, EXPERT_DIM, D), EXPERT_DIM),
        "w_sh_gate": nrm((L, D, SHARED_DIM), D),
        "w_sh_up": nrm((L, D, SHARED_DIM), D),
        "w_sh_down": nrm((L, SHARED_DIM, D), SHARED_DIM),
    }


def reference(x, c, positions, w_ada, b_ada, norm1_w, w_in, q_lat_norm_w, w_uq, kv_lat_norm_w,
              w_ukv, q_norm_w, k_norm_w, lb_fwd, lb_bwd, rec_norm_w, w_out, norm2_w, w_router,
              router_bias, w_exp_gate, w_exp_up, w_exp_down, w_sh_gate, w_sh_up, w_sh_down):
    cos, sin = rope_tables(positions, x.dtype)
    lbf_all = jnp.cumsum(jax.nn.softmax(lb_fwd.astype(jnp.float32), axis=0), axis=0)
    lbb_all = jnp.cumsum(jax.nn.softmax(lb_bwd.astype(jnp.float32), axis=0), axis=0)
    cond = jax.nn.silu(c)
    for l in range(DEPTH):
        mod = (cond @ w_ada[l] + b_ada[l])[:, None, :]
        sh1, sc1, g1, sh2, sc2, g2 = jnp.split(mod, 6, axis=-1)
        h = rms_norm(x, norm1_w[l]) * (1.0 + sc1) + sh1
        proj = h @ w_in[l]
        q_lat, kv_lat, k_rope, r_q, r_ff, r_fb, r_i, r_g = jnp.split(proj, IN_SPLITS, axis=-1)
        att = mla_attention(q_lat, kv_lat, k_rope, cos, sin, q_lat_norm_w[l], w_uq[l],
                            kv_lat_norm_w[l], w_ukv[l], q_norm_w[l], k_norm_w[l])
        rec = hgrn2_mixer(r_q, r_ff, r_fb, r_i, r_g, lbf_all[l].astype(jnp.float32),
                          lbb_all[l].astype(jnp.float32), rec_norm_w[l])
        x = x + g1 * (jnp.concatenate([att, rec], axis=-1) @ w_out[l])
        h2 = rms_norm(x, norm2_w[l]) * (1.0 + sc2) + sh2
        x = x + g2 * moe_ffn(h2, w_router[l], router_bias[l], w_exp_gate[l], w_exp_up[l],
                             w_exp_down[l], w_sh_gate[l], w_sh_up[l], w_sh_down[l])
    return x
```

```cpp
#include <hip/hip_runtime.h>
#include <cstdio>
#include <cstdint>

#ifndef INPROJ_FP8
#define INPROJ_FP8 1
#endif
#define GAS __attribute__((address_space(1)))
#define LAS __attribute__((address_space(3)))
typedef unsigned short bf16_t;
typedef short bf16x8 __attribute__((ext_vector_type(8)));
typedef short s16x4 __attribute__((ext_vector_type(4)));
typedef float f32x4 __attribute__((ext_vector_type(4)));
typedef float f32x2 __attribute__((ext_vector_type(2)));
typedef float f32x16 __attribute__((ext_vector_type(16)));
typedef unsigned u32x4 __attribute__((ext_vector_type(4)));
typedef unsigned u32x2 __attribute__((ext_vector_type(2)));
typedef GAS unsigned gu32;

constexpr int NB = 8, SEQ = 2048, DM = 2048, T = NB * SEQ;
constexpr int NH = 8, DQK = 192, DNOPE = 128, DROPE = 64, DV = 128;
constexpr int QLORA = 512, KVLORA = 256;
constexpr int RH = 8, RK = 128, RV = 128, RQK = 1024, RW = 1024, RCHUNK = 64;
constexpr int INC = 5952, INCP = 6144;
constexpr int NE = 64, TOPK = 8, NGRP = 8, TOPG = 4, ED = 512;
constexpr float EPS = 1e-6f, ROUTED_SCALE = 2.5f;

constexpr size_t MiB = 1u << 20;
constexpr size_t WS_CTL = 0, CTL_ZERO_BYTES = 1 * MiB;
constexpr size_t KiB = 1024;
constexpr size_t WS_MOD = 1 * MiB;
constexpr size_t WS_ELIST = 2 * MiB;
constexpr size_t WS_SLOTEP = 6 * MiB + 512 * KiB;
constexpr size_t WS_SLOTW = 7 * MiB + 512 * KiB;
constexpr size_t WS_WIN = 11 * MiB;
constexpr size_t WS_WUQ = 35 * MiB;
constexpr size_t WS_WUKV = 36 * MiB + 512 * KiB;
constexpr size_t WS_WRT = 37 * MiB + 512 * KiB;
constexpr size_t WS_WOUT = 38 * MiB + 512 * KiB;
constexpr size_t WS_WDN = 46 * MiB + 512 * KiB;
constexpr size_t WS_H = WS_WDN + 130 * MiB;
constexpr size_t WS_WGU = WS_H + 64 * MiB;
constexpr size_t WS_MIX = WS_WGU + 260 * MiB;
constexpr size_t WS_QLAT = WS_MIX;
constexpr size_t WS_KVLAT = WS_QLAT + 16 * MiB;
constexpr size_t WS_KROPE = WS_KVLAT + 8 * MiB;
constexpr size_t WS_RQ = WS_KROPE + 2 * MiB;
constexpr size_t WS_RFF = WS_RQ + 32 * MiB, WS_RFB = WS_RFF + 32 * MiB, WS_RI = WS_RFB + 32 * MiB, WS_RG = WS_RI + 32 * MiB;
constexpr size_t WS_QRAW = WS_RG + 32 * MiB;
constexpr size_t WS_KVRAW = WS_QRAW + 48 * MiB;
constexpr size_t WS_Q = WS_KVRAW + 64 * MiB;
constexpr size_t WS_K = WS_Q + 48 * MiB;
constexpr size_t WS_V = WS_K + 48 * MiB;
constexpr size_t WS_CAT = WS_V + 32 * MiB;
constexpr size_t WS_Y1 = WS_RFF;
constexpr size_t WS_H8 = WS_QRAW;
constexpr size_t WS_OF = WS_QRAW, WS_OB = WS_QRAW + 32 * MiB;
constexpr size_t WS_Y = WS_WGU;
constexpr size_t WS_ACT = WS_Y + 576 * MiB;
constexpr size_t WS_LOGIT = WS_ACT + 145 * MiB;
constexpr size_t WS_END = 1024 * MiB;
static_assert(WS_CAT + 64 * MiB <= WS_END && WS_LOGIT + 16 * MiB <= WS_END && WS_SLOTW + 512 * KiB <= WS_WIN && WS_ELIST + 65 * 64 * KiB <= WS_SLOTEP, "ws map");

constexpr int CW_TMO = 0, CW_CODE = 1;
constexpr int CW_BAR = 4096;
constexpr int CW_CNT = 16384;
constexpr int CW_QUEUE = 32768;
constexpr int CW_HGDONE = 32768 + 1024;
constexpr int CW_RECQ = 32768 + 1088;

constexpr int RING_BYTES = 131072;
constexpr int LDSCTL_OFF = RING_BYTES, MISC_OFF = LDSCTL_OFF + 320;
constexpr int LDS_BYTES = 147456;
constexpr int NWAVES = 8;

#define RLX_AGENT __ATOMIC_RELAXED, __HIP_MEMORY_SCOPE_AGENT
#define LDS_WAIT() asm volatile("s_waitcnt lgkmcnt(0)" ::: "memory")
#define VM_WAIT() asm volatile("s_waitcnt vmcnt(0)" ::: "memory")
__device__ __forceinline__ unsigned cvt_pk_bf16(float lo, float hi) { unsigned r; asm volatile("v_cvt_pk_bf16_f32 %0, %1, %2" : "=v"(r) : "v"(lo), "v"(hi)); return r; }
__device__ __forceinline__ float bf_lo(unsigned w) { return __uint_as_float(w << 16); }
__device__ __forceinline__ float bf_hi(unsigned w) { return __uint_as_float(w & 0xffff0000u); }
__device__ __forceinline__ float bf2f(bf16_t b) { return __uint_as_float(((unsigned)b) << 16); }
__device__ __forceinline__ bf16_t f2bf(float f) { return (bf16_t)(cvt_pk_bf16(f, 0.f) & 0xffffu); }
__device__ __forceinline__ float wave_sum(float v) {
#pragma unroll
    for (int o = 1; o < 64; o <<= 1) v += __shfl_xor(v, o);
    return v;
}
__device__ __forceinline__ float sigmoidf_(float x) { return __builtin_amdgcn_rcpf(1.0f + __expf(-x)); }
__device__ __forceinline__ float siluf_(float x) { return x * __builtin_amdgcn_rcpf(1.0f + __expf(-x)); }
#define XB_TMO      128
#define XB_XCNT(j)  (256  + 64 * (j))
#define XB_XSUB(j)  (1280 + 64 * (j))
#define XB_XGEN(j)  (2304 + 64 * (j))
#define XB_TOP      3328
#define XB_TOPGEN   3392
#define XCD_BAR_WORDS 3456
#define XB_SPIN_CAP (1u << 18)

__device__ __forceinline__ unsigned xb_ld(unsigned* p)              { return __hip_atomic_load(p, __ATOMIC_RELAXED, __HIP_MEMORY_SCOPE_AGENT); }
__device__ __forceinline__ unsigned xb_add(unsigned* p, unsigned v) { return __hip_atomic_fetch_add(p, v, __ATOMIC_RELAXED, __HIP_MEMORY_SCOPE_AGENT); }
__device__ __forceinline__ unsigned xb_xcc_id() { return (unsigned)__builtin_amdgcn_s_getreg((3 << 11) | 20) & 0xFu; }
#define XB_SPIN(cond, bar) do { unsigned _sp = 0; while (cond) { __builtin_amdgcn_s_sleep(1); \
    if ((++_sp & 255u) == 0u) { if (xb_ld(&(bar)[XB_TMO])) break; if (_sp > XB_SPIN_CAP) { atomicAdd(&(bar)[XB_TMO], 1u); break; } } } } while (0)

struct XcdBarrier {
    unsigned* bar; unsigned x;
    volatile LAS unsigned* st;
};

__device__ __forceinline__ XcdBarrier xcd_barrier_post(unsigned* bar, volatile LAS unsigned* st) {
    XcdBarrier b; b.bar = bar; b.x = xb_xcc_id(); b.st = st;
    if (threadIdx.x == 0) (void)xb_add(&bar[XB_XCNT(b.x)], 1u);
    return b;
}
__device__ __forceinline__ void xcd_barrier_complete(unsigned* bar, unsigned x, unsigned& nloc, unsigned& nx) {
    const unsigned G = gridDim.x * gridDim.y * gridDim.z;
    unsigned sum, cnt, mine, sp = 0u;
    for (;;) {
        sum = 0u; cnt = 0u; mine = 0u;
#pragma unroll
        for (unsigned j = 0; j < 16; ++j) { const unsigned c = xb_ld(&bar[XB_XCNT(j)]); sum += c; cnt += (c > 0u) ? 1u : 0u; mine = (j == x) ? c : mine; }
        if (sum == G) break;
        __builtin_amdgcn_s_sleep(1);
        if ((++sp & 255u) == 0u) { if (xb_ld(&bar[XB_TMO])) break; if (sp > XB_SPIN_CAP) { atomicAdd(&bar[XB_TMO], 1u); break; } }
    }
    nloc = mine > 0u ? mine : 1u; nx = cnt > 0u ? cnt : 1u;
}

__device__ __forceinline__ void xcd_barrier(const XcdBarrier& b) {
    asm volatile("s_waitcnt vmcnt(0)" ::: "memory");
    __syncthreads();
    if (threadIdx.x == 0) {
        unsigned* bar = b.bar;
        __builtin_amdgcn_s_waitcnt(0);
        unsigned nloc = b.st[0], nx = b.st[1];
        if (nloc == 0u) { xcd_barrier_complete(bar, b.x, nloc, nx); b.st[0] = nloc; b.st[1] = nx; }
        const unsigned old = xb_add(&bar[XB_XSUB(b.x)], 1u);
        const unsigned gen = old / nloc;
        if (old + 1u == (gen + 1u) * nloc) {
            __builtin_amdgcn_fence(__ATOMIC_RELEASE, "agent");
            asm volatile("s_waitcnt vmcnt(0)" ::: "memory");
            const unsigned og = xb_add(&bar[XB_TOP], 1u);
            const unsigned tg = og / nx;
            if (og + 1u == (tg + 1u) * nx) xb_add(&bar[XB_TOPGEN], 1u);
            else XB_SPIN(xb_ld(&bar[XB_TOPGEN]) == tg, bar);
            __builtin_amdgcn_fence(__ATOMIC_ACQUIRE, "agent");
            xb_add(&bar[XB_XGEN(b.x)], 1u);
            asm volatile("s_waitcnt vmcnt(0)" ::: "memory");
        } else {
            XB_SPIN(xb_ld(&bar[XB_XGEN(b.x)]) == gen, bar);
            __builtin_amdgcn_fence(__ATOMIC_ACQUIRE, "agent");
            asm volatile("s_waitcnt vmcnt(0)" ::: "memory");
        }
    }
    __syncthreads();
}
namespace pg8 {
constexpr int BM = 256, BK = 64, HALF = 128, HTB = HALF * BK * 2, STAGE_BYTES = 8 * HTB, NXCD = 8, WGM = 8;
__host__ __device__ __forceinline__ int lds_byte(int r, int c) { const int st = (r >> 4) * 2 + (c >> 5), rr = r & 15, cc = c & 31, ob = rr * 64 + cc * 2; return st * 1024 + (ob ^ (((ob >> 9) & 1) << 5)); }
__host__ __device__ __forceinline__ void stage_rc(int b, int& R, int& C) { const int st = b / 1024, sb = b % 1024, swz = sb ^ (((sb >> 9) & 1) << 5); R = (st >> 1) * 16 + swz / 64; C = (st & 1) * 32 + (swz % 64) / 2; }
__host__ __device__ __forceinline__ int gray2(int x) { return x ^ (x >> 1); }
__host__ __device__ __forceinline__ int lds_byte8(int r, int cbyte) { const int st = (r >> 4) * 2 + (cbyte >> 6), rr = r & 15, ch = (cbyte & 63) >> 4; return st * 1024 + rr * 64 + ((ch ^ gray2(rr >> 2)) << 4) + (cbyte & 15); }
__host__ __device__ __forceinline__ void stage_rc8(int b, int& R, int& Cbyte) { const int st = b / 1024, sb = b % 1024, rr = sb / 64, slot = (sb % 64) >> 4; R = (st >> 1) * 16 + rr; Cbyte = (st & 1) * 64 + ((slot ^ gray2(rr >> 2)) << 4) + (sb & 15); }
__host__ __device__ __forceinline__ int perm32(int rho) { const int n = rho >> 4, i = rho & 15; return 8 * (i >> 2) + 4 * n + (i & 3); }

struct Unit { int pm, pn, e, mt, rows, row0; };

struct DenseOrder {
    static constexpr bool GATHER = false;
    const char* A; const char* Bt; int lda2  , K2  ; int nM, nN, nwg, G, c;
    __device__ void init(const void* A_, int ldaBytes, const void* Bt_, int ldbBytes, int M, int N, int G_, int c_) { A = (const char*)A_; Bt = (const char*)Bt_; lda2 = ldaBytes; K2 = ldbBytes; nM = M / BM; nN = N / BM; nwg = nM * nN; G = G_; c = c_; }
    __device__ __forceinline__ bool next(int i, Unit& u) const {
        const long L = (long)i * G + c; if (L >= nwg) return false;
        int wgid = (int)L; { const int q = nwg / NXCD, r = nwg % NXCD, xcd = wgid % NXCD, off = wgid / NXCD; wgid = (xcd < r ? xcd * (q + 1) : r * (q + 1) + (xcd - r) * q) + off; }
        const int nig = WGM * nN, gid = wgid / nig, fm = gid * WGM, gsz = (nM - fm) < WGM ? (nM - fm) : WGM;
        u.pm = fm + ((wgid % nig) % gsz); u.pn = (wgid % nig) / gsz; u.e = 0; u.mt = 0; u.rows = 256; u.row0 = u.pm * 256; return true;
    }
    __device__ __forceinline__ void meta_prefetch(const Unit&, int, LAS unsigned char*, int) const {}
    __device__ __forceinline__ void a_addr(const Unit& u, int, LAS unsigned char*, int R0, int Cb, const char*& base, unsigned (&ao)[4]) const {
        base = A + (size_t)u.pm * 256 * lda2;
#pragma unroll
        for (int j = 0; j < 4; ++j) ao[j] = (unsigned)((R0 + 64 * j) * lda2 + Cb);
    }
    __device__ __forceinline__ const char* b_addr(const Unit& u) const { return Bt + (size_t)u.pn * 256 * K2; }
    __device__ __forceinline__ size_t arow64() const { return (size_t)64 * lda2; }
};

struct SplitKOrder {
    static constexpr bool GATHER = false;
    const char* A; const char* Bt; int lda2, KS2  ; int nM, nS, nwg, G, c;
    __device__ __forceinline__ bool next(int i, Unit& u) const {
        const long L = (long)i * G + c; if (L >= nwg) return false;
        u.pm = (int)L / nS; u.pn = (int)L % nS; u.e = 0; u.mt = 0; u.rows = 256; u.row0 = u.pm * 256; return true;
    }
    __device__ __forceinline__ void meta_prefetch(const Unit&, int, LAS unsigned char*, int) const {}
    __device__ __forceinline__ void a_addr(const Unit& u, int, LAS unsigned char*, int R0, int Cb, const char*& base, unsigned (&ao)[4]) const {
        base = A + (size_t)u.pm * 256 * lda2 + (size_t)u.pn * KS2;
#pragma unroll
        for (int j = 0; j < 4; ++j) ao[j] = (unsigned)((R0 + 64 * j) * lda2 + Cb);
    }
    __device__ __forceinline__ const char* b_addr(const Unit& u) const { return Bt + (size_t)u.pn * KS2; }
    __device__ __forceinline__ size_t arow64() const { return (size_t)64 * lda2; }
};

typedef int v8i_t __attribute__((ext_vector_type(8)));
__device__ __forceinline__ int pg8_xor16(int a) { int r; asm volatile("v_xor_b32 %0, 16, %1" : "=v"(r) : "v"(a)); return r; }
struct Frag2 { u32x4 lo, hi; };
template <bool F8> struct FragSel { typedef Frag2 T; };
template <> struct FragSel<true> { typedef v8i_t T; };
template <class Epi, class Sched, bool ALIGN_EPI = true, bool FP8 = false, bool SWZ8 = false>
__device__ __forceinline__ void gemm_phase(LAS unsigned char* lds, const int Kb, const int ldbB, const Sched& S, const Epi& E) {
    int tid = threadIdx.x; asm volatile("" : "+v"(tid));
    const int wid = __builtin_amdgcn_readfirstlane(tid >> 6), lane = tid & 63, wr = wid >> 2, wc = wid & 3, fr = lane & 15, fq = lane >> 4;
    const int nt = Kb / 128;
    int R0, C0; if constexpr (FP8 && SWZ8) { int cb; stage_rc8(tid * 16, R0, cb); C0 = cb >> 1; } else stage_rc(tid * 16, R0, C0);
    unsigned voffB[2];
    { const int Rb = Epi::PERM ? (64 * (R0 >> 5) + 16 * ((R0 & 15) >> 2) + 4 * ((R0 >> 4) & 1) + (R0 & 3)) : R0; voffB[0] = (unsigned)(Rb * ldbB + C0 * 2); voffB[1] = voffB[0]; }
    const size_t pstepB = (size_t)(Epi::PERM ? 128 : 64) * ldbB;
    const size_t kstep = (size_t)(BK * 2);
    const size_t hstepB = (size_t)(Epi::PERM ? 8 : HALF) * ldbB;
    const unsigned ldsw = (unsigned)wid * 1024u;
    const int aoffL = (FP8 && SWZ8) ? lds_byte8(wr * 64 + fr, fq * 32) : (FP8 ? lds_byte(wr * 64 + fr, fq * 16) : lds_byte(wr * 64 + fr, fq * 8)), aoffH1k = FP8 ? aoffL + 16 : aoffL + 1024;
    int boffL = ((FP8 && SWZ8) ? lds_byte8(wc * 32 + fr, fq * 32) : (FP8 ? lds_byte(wc * 32 + fr, fq * 16) : lds_byte(wc * 32 + fr, fq * 8))) + 65536; asm volatile("" : "+v"(boffL)); const int boffH1k = FP8 ? boffL + 16 : boffL + 1024;
#define PG8_SA(b, h) (((b) * 2 + (h)) * HTB)
#define PG8_SB(b, h) ((4 + (b) * 2 + (h)) * HTB)
    const unsigned ldsb = (unsigned)__builtin_amdgcn_readfirstlane((int)(unsigned)(uintptr_t)lds) + ldsw;
#define PG8_DMA(gb, vo, ldst) asm volatile("s_mov_b32 m0, %2\n\ts_nop 0\n\tglobal_load_lds_dwordx4 %0, %1" :: "v"(vo), "s"(gb), "s"(ldst) : "memory")
#define PG8_STAGE(bufoff, gbase, voff) do { const char* _gb = (const char*)(gbase); _Pragma("unroll") for (int _i = 0; _i < 2; ++_i) PG8_DMA(_gb + (size_t)_i * pstepB, (voff)[0], ldsb + (unsigned)((bufoff) + _i * 8192)); } while (0)
#define PG8_STAGE_A(bufoff, gbase, aov, h) do { const char* _gb = (const char*)(gbase); _Pragma("unroll") for (int _i = 0; _i < 2; ++_i) { \
        if constexpr (Sched::GATHER) PG8_DMA(_gb, (aov)[(h) * 2 + _i], ldsb + (unsigned)((bufoff) + _i * 8192)); \
        else PG8_DMA(_gb + (size_t)((h) * 2 + _i) * S.arow64(), (aov)[0], ldsb + (unsigned)((bufoff) + _i * 8192)); } } while (0)
#define PG8_LDF(dst, off0, off1) do { const u32x4 _lo = *(const LAS u32x4*)(lds + (off0)), _hi = *(const LAS u32x4*)(lds + (off1)); \
        if constexpr (FP8) dst = (v8i_t){(int)_lo.x, (int)_lo.y, (int)_lo.z, (int)_lo.w, (int)_hi.x, (int)_hi.y, (int)_hi.z, (int)_hi.w}; else { dst.lo = _lo; dst.hi = _hi; } } while (0)
#define PG8_HI(lo, hi1k) ((FP8 && SWZ8) ? pg8_xor16(lo) : (hi1k))
#define PG8_LDA(dst, b, h) do { const int _hio = PG8_HI(aoffL, aoffH1k); _Pragma("unroll") for (int m = 0; m < 4; ++m) PG8_LDF(dst[m], PG8_SA(b, h) + aoffL + m * 2048, PG8_SA(b, h) + _hio + m * 2048); } while (0)
#define PG8_LDB(dst, b, h) do { const int _hio = PG8_HI(boffL, boffH1k); _Pragma("unroll") for (int n = 0; n < 2; ++n) PG8_LDF(dst[n], (PG8_SB(b, h) - 65536) + boffL + n * 2048, (PG8_SB(b, h) - 65536) + _hio + n * 2048); } while (0)
#define PG8_MMA(ai, bj, At, Bt) do { __builtin_amdgcn_s_setprio(1); _Pragma("unroll") for (int m = 0; m < 4; ++m) _Pragma("unroll") for (int n = 0; n < 2; ++n) { \
        if constexpr (FP8) acc[ai][bj][m][n] = __builtin_amdgcn_mfma_scale_f32_16x16x128_f8f6f4(Bt[n], At[m], acc[ai][bj][m][n], 0, 0, 0, 0, 0, 0);     \
        else { acc[ai][bj][m][n] = __builtin_amdgcn_mfma_f32_16x16x32_bf16(__builtin_bit_cast(bf16x8, Bt[n].lo), __builtin_bit_cast(bf16x8, At[m].lo), acc[ai][bj][m][n], 0, 0, 0); \
            acc[ai][bj][m][n] = __builtin_amdgcn_mfma_f32_16x16x32_bf16(__builtin_bit_cast(bf16x8, Bt[n].hi), __builtin_bit_cast(bf16x8, At[m].hi), acc[ai][bj][m][n], 0, 0, 0); } } \
        __builtin_amdgcn_s_setprio(0); } while (0)
#define PG8_LDA2(dst, b, h) do { const int _hio = PG8_HI(aoffL, aoffH1k); _Pragma("unroll") for (int m = 0; m < 2; ++m) PG8_LDF(dst[m], PG8_SA(b, h) + aoffL + m * 2048, PG8_SA(b, h) + _hio + m * 2048); } while (0)
#define PG8_MF(ai, bj, m, Av, Bt) do { _Pragma("unroll") for (int n = 0; n < 2; ++n) acc[ai][bj][m][n] = __builtin_amdgcn_mfma_scale_f32_16x16x128_f8f6f4(Bt[n], Av, acc[ai][bj][m][n], 0, 0, 0, 0, 0, 0); } while (0)
#define PG8_MMA8(ai, At, B0, B1, b, h) do { __builtin_amdgcn_s_setprio(1); const int _hio = PG8_HI(aoffL, aoffH1k); \
        PG8_MF(ai, 0, 0, At[0], B0); PG8_MF(ai, 1, 0, At[0], B1); PG8_LDF(At[0], PG8_SA(b, h) + aoffL + 2 * 2048, PG8_SA(b, h) + _hio + 2 * 2048); \
        PG8_MF(ai, 0, 1, At[1], B0); PG8_MF(ai, 1, 1, At[1], B1); PG8_LDF(At[1], PG8_SA(b, h) + aoffL + 3 * 2048, PG8_SA(b, h) + _hio + 3 * 2048); \
        PG8_MF(ai, 0, 2, At[0], B0); PG8_MF(ai, 1, 2, At[0], B1); PG8_MF(ai, 0, 3, At[1], B0); PG8_MF(ai, 1, 3, At[1], B1); __builtin_amdgcn_s_setprio(0); } while (0)
#define PG8_WAIT_V(n) asm volatile("s_waitcnt vmcnt(" #n ")" ::: "memory")
#define PG8_WAIT_L(n) asm volatile("s_waitcnt lgkmcnt(" #n ")" ::: "memory")
#define PG8_BAR __builtin_amdgcn_s_barrier()
#define PG8_SCHED __builtin_amdgcn_sched_barrier(0)
    Unit cur, nxt; int ui = 0;
    if (!S.next(0, cur)) return;
    f32x4 acc[2][2][4][2];
#pragma unroll
    for (int a = 0; a < 2; ++a)
#pragma unroll
        for (int b = 0; b < 2; ++b)
#pragma unroll
            for (int m = 0; m < 4; ++m)
#pragma unroll
                for (int n = 0; n < 2; ++n) acc[a][b][m][n] = (f32x4){0.f, 0.f, 0.f, 0.f};
    typename FragSel<FP8>::T At[4], B0[2], B1[2];
    const char* cA; unsigned cao[4]; const char* nA; unsigned nao[4];
    int mslot = 0;
    if constexpr (Sched::GATHER) { S.meta_prefetch(cur, 0, lds, wid); PG8_WAIT_V(0); __syncthreads(); }
    S.a_addr(cur, 0, lds, R0, C0 * 2, cA, cao);
    const char* cB = S.b_addr(cur);
    PG8_STAGE(PG8_SB(0, 0), cB, voffB); PG8_STAGE(PG8_SB(0, 1), cB + hstepB, voffB); PG8_STAGE_A(PG8_SA(0, 0), cA, cao, 0); PG8_STAGE_A(PG8_SA(0, 1), cA, cao, 1);
    if (wr == 1) PG8_BAR;
    PG8_WAIT_V(2); PG8_BAR;
    PG8_STAGE(PG8_SB(1, 0), cB + kstep, voffB); PG8_STAGE_A(PG8_SA(1, 0), cA + kstep, cao, 0); PG8_STAGE(PG8_SB(1, 1), cB + hstepB + kstep, voffB);
    PG8_WAIT_V(6); PG8_BAR;
    for (;;) {
        const bool has_next = S.next(ui + 1, nxt);
        const int nslot = (mslot == 2) ? 0 : mslot + 1;
        if constexpr (Sched::GATHER) { if (has_next) S.meta_prefetch(nxt, nslot, lds, wid); }
        const char* nB = has_next ? S.b_addr(nxt) : cB;
#pragma unroll 1
        for (int t = 0; t < nt; t += 2) {
            const bool last = (t == nt - 2);
            const char* a1 = cA + (size_t)(t + 1) * kstep;
            const char* b2 = last ? nB : cB + (size_t)(t + 2) * kstep;
            const char* b3 = b2 + kstep;
            if constexpr (FP8) {
            PG8_LDB(B0, 0, 0); PG8_LDB(B1, 0, 1); PG8_SCHED; PG8_LDA2(At, 0, 0); PG8_STAGE_A(PG8_SA(1, 1), a1, cao, 1);
            PG8_WAIT_V(8); PG8_WAIT_L(0); PG8_BAR; PG8_MMA8(0, At, B0, B1, 0, 0); PG8_BAR; PG8_SCHED;
            if (last) {
                if (has_next) { S.a_addr(nxt, nslot, lds, R0, C0 * 2, nA, nao); cA = nA;
#pragma unroll
                    for (int j = 0; j < 4; ++j) cao[j] = nao[j]; }
            }
            const char* a2 = last ? cA : cA + (size_t)(t + 2) * kstep;
            const char* a3 = a2 + kstep;
            PG8_LDA2(At, 0, 1); PG8_STAGE(PG8_SB(0, 0), b2, voffB); PG8_STAGE(PG8_SB(0, 1), b2 + hstepB, voffB); PG8_STAGE_A(PG8_SA(0, 0), a2, cao, 0);
            PG8_WAIT_V(8); PG8_WAIT_L(0); PG8_BAR; PG8_MMA8(1, At, B0, B1, 0, 1); PG8_BAR; PG8_SCHED;
            PG8_LDB(B0, 1, 0); PG8_LDB(B1, 1, 1); PG8_SCHED; PG8_LDA2(At, 1, 0); PG8_STAGE_A(PG8_SA(0, 1), a2, cao, 1);
            PG8_WAIT_V(8); PG8_WAIT_L(0); PG8_BAR; PG8_MMA8(0, At, B0, B1, 1, 0); PG8_BAR; PG8_SCHED;
            PG8_LDA2(At, 1, 1); PG8_STAGE(PG8_SB(1, 0), b3, voffB); PG8_STAGE(PG8_SB(1, 1), b3 + hstepB, voffB); PG8_STAGE_A(PG8_SA(1, 0), a3, cao, 0);
            PG8_WAIT_V(8); PG8_WAIT_L(0); PG8_BAR; PG8_MMA8(1, At, B0, B1, 1, 1); PG8_BAR; PG8_SCHED;
            } else {
            PG8_LDB(B0, 0, 0); PG8_LDB(B1, 0, 1); PG8_SCHED; PG8_LDA(At, 0, 0); PG8_STAGE_A(PG8_SA(1, 1), a1, cao, 1);
            PG8_WAIT_V(8); PG8_WAIT_L(0); PG8_BAR; PG8_MMA(0, 0, At, B0); PG8_MMA(0, 1, At, B1); PG8_BAR; PG8_SCHED;
            if (last) {
                if (has_next) { S.a_addr(nxt, nslot, lds, R0, C0 * 2, nA, nao); cA = nA;
#pragma unroll
                    for (int j = 0; j < 4; ++j) cao[j] = nao[j]; }
            }
            const char* a2 = last ? cA : cA + (size_t)(t + 2) * kstep;
            const char* a3 = a2 + kstep;
            PG8_LDA(At, 0, 1); PG8_STAGE(PG8_SB(0, 0), b2, voffB); PG8_STAGE(PG8_SB(0, 1), b2 + hstepB, voffB); PG8_STAGE_A(PG8_SA(0, 0), a2, cao, 0);
            PG8_WAIT_V(8); PG8_WAIT_L(0); PG8_BAR; PG8_MMA(1, 0, At, B0); PG8_MMA(1, 1, At, B1); PG8_BAR; PG8_SCHED;
            PG8_LDB(B0, 1, 0); PG8_LDB(B1, 1, 1); PG8_SCHED; PG8_LDA(At, 1, 0); PG8_STAGE_A(PG8_SA(0, 1), a2, cao, 1);
            PG8_WAIT_V(8); PG8_WAIT_L(0); PG8_BAR; PG8_MMA(0, 0, At, B0); PG8_MMA(0, 1, At, B1); PG8_BAR; PG8_SCHED;
            PG8_LDA(At, 1, 1); PG8_STAGE(PG8_SB(1, 0), b3, voffB); PG8_STAGE(PG8_SB(1, 1), b3 + hstepB, voffB); PG8_STAGE_A(PG8_SA(1, 0), a3, cao, 0);
            PG8_WAIT_V(8); PG8_WAIT_L(0); PG8_BAR; PG8_MMA(1, 0, At, B0); PG8_MMA(1, 1, At, B1); PG8_BAR; PG8_SCHED;
            }
        }
        if constexpr (ALIGN_EPI) { if (wr == 0) PG8_BAR; }
        E(acc, cur, mslot, lds, wr, wc, fr, fq);
        if (!has_next) break;
#pragma unroll
        for (int a = 0; a < 2; ++a)
#pragma unroll
            for (int b = 0; b < 2; ++b)
#pragma unroll
                for (int m = 0; m < 4; ++m)
#pragma unroll
                    for (int n = 0; n < 2; ++n) acc[a][b][m][n] = (f32x4){0.f, 0.f, 0.f, 0.f};
        cur = nxt; cB = nB; ++ui; mslot = nslot;
        if constexpr (ALIGN_EPI) { if (wr == 1) PG8_BAR; }
    }
    PG8_WAIT_V(0);
    if constexpr (!ALIGN_EPI) { if (wr == 0) PG8_BAR; }
    PG8_BAR;
#undef PG8_SA
#undef PG8_SB
#undef PG8_STAGE
#undef PG8_STAGE_A
#undef PG8_DMA
#undef PG8_LDA
#undef PG8_LDA2
#undef PG8_MF
#undef PG8_MMA8
#undef PG8_HI
#undef PG8_LDF
#undef PG8_LDB
#undef PG8_MMA
#undef PG8_WAIT_V
#undef PG8_WAIT_L
#undef PG8_BAR
#undef PG8_SCHED
}
}
constexpr int GTAB_OFF = LDSCTL_OFF + 1024;
constexpr int META_OFF = LDSCTL_OFF + 4096;
namespace pg8 {
template <bool GATHER_A, bool NEED_W, int NTSHIFT>
struct GroupedOrder {
    static constexpr bool GATHER = GATHER_A;
    const char* A; int lda2; const char* Bt; size_t bexp; int K2; const int* elist; const float* ewt; const LAS int* tab; int tpl; int total; int G, c;
    __device__ __forceinline__ bool next(int i, Unit& u) const {
        int mtg;
        if (G == 256) { constexpr int NT = 1 << NTSHIFT, RPX = 32 / NT;
            mtg = i * (256 / NT) + RPX * (c & 7) + (c >> (3 + NTSHIFT)); u.pn = (c >> 3) & (NT - 1); if (mtg >= (total >> NTSHIFT)) return false; }
        else { const long L = (long)i * G + c; if (L >= total) return false; mtg = (int)L >> NTSHIFT; u.pn = (int)L & ((1 << NTSHIFT) - 1); }
        const int e = __popcll(__ballot(tpl <= mtg));
        const int tpe = __builtin_amdgcn_readfirstlane(tab[e]), cn = __builtin_amdgcn_readfirstlane(tab[66 + e]), ro = __builtin_amdgcn_readfirstlane(tab[132 + e]);
        u.e = e; u.pm = 0; u.mt = mtg - tpe; const int rem = cn - u.mt * 256; u.rows = rem < 256 ? rem : 256; u.row0 = ro + u.mt * 256; return true;
    }
    __device__ __forceinline__ void meta_prefetch(const Unit& u, int slot, LAS unsigned char* lds, int wid) const {
        if (wid == 0) {
            const int lane = threadIdx.x & 63;
            __builtin_amdgcn_global_load_lds((const unsigned*)(elist + (size_t)u.e * 16384 + u.mt * 256 + lane * 4), (LAS unsigned*)(lds + META_OFF + slot * 2048), 16, 0, 0);
            if (NEED_W) __builtin_amdgcn_global_load_lds((const unsigned*)(ewt + (size_t)u.e * 16384 + u.mt * 256 + lane * 4), (LAS unsigned*)(lds + META_OFF + slot * 2048 + 1024), 16, 0, 0);
        }
    }
    __device__ __forceinline__ void a_addr(const Unit& u, int slot, LAS unsigned char* lds, int R0, int Cb, const char*& base, unsigned (&ao)[4]) const {
        if constexpr (GATHER_A) {
            base = A; const LAS int* me = (const LAS int*)(lds + META_OFF + slot * 2048);
#pragma unroll
            for (int j = 0; j < 4; ++j) { const int r = R0 + 64 * j; const int en = me[r]; const int tok = (r < u.rows) ? (en >> 3) : 0; ao[j] = (unsigned)tok * (unsigned)lda2 + (unsigned)Cb; }
        } else {
            base = A + (size_t)u.row0 * lda2;
#pragma unroll
            for (int j = 0; j < 4; ++j) ao[j] = (unsigned)((R0 + 64 * j) * lda2 + Cb);
        }
    }
    __device__ __forceinline__ const char* b_addr(const Unit& u) const { return Bt + (size_t)u.e * bexp + (size_t)u.pn * 256 * K2; }
    __device__ __forceinline__ size_t arow64() const { return (size_t)64 * lda2; }
};
}

typedef f32x4 Acc[2][2][4][2];
__device__ __forceinline__ unsigned pk4_fp8(float a, float b, float c, float d);

struct EpiInProj {
    static constexpr bool PERM = true;
    unsigned char* ws; float oscale;
    __device__ __forceinline__ void operator()(const Acc& acc, const pg8::Unit& u, int, LAS unsigned char*, int wr, int wc, int fr, int fq) const {
        asm volatile("" : "+v"(fr), "+v"(fq));
        bf16_t* base; int ld, c0, ncv = 256;
        const int pn = u.pn;
        const int row0 = u.pm * 256 + wr * 64 + fr, colw = wc * 64 + 16 * fq;
        if (pn < 2) {
            unsigned char* q8 = ws + WS_QLAT;
#pragma unroll
            for (int ai = 0; ai < 2; ++ai)
#pragma unroll
                for (int m = 0; m < 4; ++m) { const f32x4 a0 = acc[ai][0][m][0] * oscale, a1 = acc[ai][0][m][1] * oscale, b0 = acc[ai][1][m][0] * oscale, b1 = acc[ai][1][m][1] * oscale;
                    u32x4 w; w.x = pk4_fp8(a0[0], a0[1], a0[2], a0[3]); w.y = pk4_fp8(a1[0], a1[1], a1[2], a1[3]); w.z = pk4_fp8(b0[0], b0[1], b0[2], b0[3]); w.w = pk4_fp8(b1[0], b1[1], b1[2], b1[3]);
                    *(u32x4*)(q8 + (size_t)(row0 + ai * 128 + m * 16) * 512 + pn * 256 + colw) = w; }
            return; }
        if (pn == 2) { base = (bf16_t*)(ws + WS_KVLAT); ld = 256; c0 = 0; }
        else if (pn == 3) { base = (bf16_t*)(ws + WS_KROPE); ld = 64; c0 = 0; ncv = 64; }
        else { const int s = (pn - 4) >> 2; base = (bf16_t*)(ws + WS_RQ + (size_t)s * 32 * MiB); ld = 1024; c0 = ((pn - 4) & 3) * 256; }
#pragma unroll
        for (int ai = 0; ai < 2; ++ai)
#pragma unroll
            for (int m = 0; m < 4; ++m) { bf16_t* rowp = base + (size_t)(row0 + ai * 128 + m * 16) * ld + c0 + colw;
#pragma unroll
                for (int bj = 0; bj < 2; ++bj) { const f32x4 v0 = acc[ai][bj][m][0] * oscale, v1 = acc[ai][bj][m][1] * oscale;
                    u32x4 w; w.x = cvt_pk_bf16(v0[0], v0[1]); w.y = cvt_pk_bf16(v0[2], v0[3]); w.z = cvt_pk_bf16(v1[0], v1[1]); w.w = cvt_pk_bf16(v1[2], v1[3]);
                    if (colw < ncv) *(u32x4*)(rowp + bj * 8) = w; } }
    }
};
struct EpiBf16 {
    static constexpr bool PERM = true;
    bf16_t* O; int ldc; float oscale;
    __device__ __forceinline__ void operator()(const Acc& acc, const pg8::Unit& u, int, LAS unsigned char*, int wr, int wc, int fr, int fq) const {
        asm volatile("" : "+v"(fr), "+v"(fq));
        const int row0 = u.pm * 256 + wr * 64 + fr, col0 = u.pn * 256 + wc * 64 + 16 * fq;
#pragma unroll
        for (int ai = 0; ai < 2; ++ai)
#pragma unroll
            for (int m = 0; m < 4; ++m) { bf16_t* rowp = O + (size_t)(row0 + ai * 128 + m * 16) * ldc + col0;
#pragma unroll
                for (int bj = 0; bj < 2; ++bj) { const f32x4 v0 = acc[ai][bj][m][0] * oscale, v1 = acc[ai][bj][m][1] * oscale;
                    u32x4 w; w.x = cvt_pk_bf16(v0[0], v0[1]); w.y = cvt_pk_bf16(v0[2], v0[3]); w.z = cvt_pk_bf16(v1[0], v1[1]); w.w = cvt_pk_bf16(v1[2], v1[3]);
                    *(u32x4*)(rowp + bj * 8) = w; } }
    }
};
struct EpiOutProj {
    static constexpr bool PERM = true;
    bf16_t* y1; const float* mod; float oscale;
    __device__ __forceinline__ void operator()(const Acc& acc, const pg8::Unit& u, int, LAS unsigned char*, int wr, int wc, int fr, int fq) const {
        asm volatile("" : "+v"(fr), "+v"(fq));
        const int row0 = u.pm * 256 + wr * 64 + fr, col0 = u.pn * 256 + wc * 64 + 16 * fq; const int b = u.pm >> 3;
        f32x4 gv[2][2];
#pragma unroll
        for (int bj = 0; bj < 2; ++bj)
#pragma unroll
            for (int n = 0; n < 2; ++n) gv[bj][n] = *(const f32x4*)(mod + (size_t)b * 12288 + 4096 + col0 + bj * 8 + n * 4) * oscale;
#pragma unroll
        for (int ai = 0; ai < 2; ++ai)
#pragma unroll
            for (int m = 0; m < 4; ++m) { bf16_t* rowp = y1 + (size_t)(row0 + ai * 128 + m * 16) * DM + col0;
#pragma unroll
                for (int bj = 0; bj < 2; ++bj) { const f32x4 v0 = acc[ai][bj][m][0] * gv[bj][0], v1 = acc[ai][bj][m][1] * gv[bj][1];
                    u32x4 w; w.x = cvt_pk_bf16(v0[0], v0[1]); w.y = cvt_pk_bf16(v0[2], v0[3]); w.z = cvt_pk_bf16(v1[0], v1[1]); w.w = cvt_pk_bf16(v1[2], v1[3]);
                    *(u32x4*)(rowp + bj * 8) = w; } }
    }
};
struct EpiRouter {
    static constexpr bool PERM = false;
    float* logit;
    __device__ __forceinline__ void operator()(const Acc& acc, const pg8::Unit& u, int, LAS unsigned char*, int wr, int wc, int fr, int fq) const {
        asm volatile("" : "+v"(fr), "+v"(fq));
        if (wc >= 2) return;
        const int row0 = u.pm * 256 + wr * 64 + fr, col0 = wc * 32 + 4 * fq;
#pragma unroll
        for (int ai = 0; ai < 2; ++ai)
#pragma unroll
            for (int m = 0; m < 4; ++m) { float* rowp = logit + (size_t)u.pn * T * 64 + (size_t)(row0 + ai * 128 + m * 16) * 64 + col0;
#pragma unroll
                for (int n = 0; n < 2; ++n) *(f32x4*)(rowp + n * 16) = acc[ai][0][m][n]; }
    }
};
struct EpiGemm1 {
    static constexpr bool PERM = true;
    unsigned char* act;
    __device__ __forceinline__ void operator()(const Acc& acc, const pg8::Unit& u, int, LAS unsigned char*, int wr, int wc, int fr, int fq) const {
        asm volatile("" : "+v"(fr), "+v"(fq));
        const int r0 = wr * 64 + fr, col0 = u.pn * 128 + wc * 32 + 8 * fq;
#pragma unroll
        for (int ai = 0; ai < 2; ++ai)
#pragma unroll
            for (int m = 0; m < 4; ++m) { const int r = r0 + ai * 128 + m * 16;
                float o[8];
#pragma unroll
                for (int n = 0; n < 2; ++n)
#pragma unroll
                    for (int j = 0; j < 4; ++j) { const float g = acc[ai][0][m][n][j] * (1.0f / 32.0f), up = acc[ai][1][m][n][j] * (1.0f / 32.0f); o[n * 4 + j] = g * __builtin_amdgcn_rcpf(1.0f + __expf(-g)) * up; }
                u32x2 w; w.x = pk4_fp8(o[0], o[1], o[2], o[3]); w.y = pk4_fp8(o[4], o[5], o[6], o[7]);
                if (r < u.rows) *(u32x2*)(act + (size_t)(u.row0 + r) * ED + col0) = w; }
    }
};
struct EpiGemm2 {
    static constexpr bool PERM = true;
    unsigned char* Y;
    __device__ __forceinline__ void operator()(const Acc& acc, const pg8::Unit& u, int, LAS unsigned char*, int wr, int wc, int fr, int fq) const {
        asm volatile("" : "+v"(fr), "+v"(fq));
        const int r0 = wr * 64 + fr, col0 = u.pn * 256 + wc * 64 + 16 * fq; const float s = 1.0f / 16.0f;
#pragma unroll
        for (int ai = 0; ai < 2; ++ai)
#pragma unroll
            for (int m = 0; m < 4; ++m) { const int r = r0 + ai * 128 + m * 16;
                const f32x4 a0 = acc[ai][0][m][0] * s, a1 = acc[ai][0][m][1] * s, b0 = acc[ai][1][m][0] * s, b1 = acc[ai][1][m][1] * s;
                u32x4 w; w.x = pk4_fp8(a0[0], a0[1], a0[2], a0[3]); w.y = pk4_fp8(a1[0], a1[1], a1[2], a1[3]); w.z = pk4_fp8(b0[0], b0[1], b0[2], b0[3]); w.w = pk4_fp8(b1[0], b1[1], b1[2], b1[3]);
                if (r < u.rows) *(u32x4*)(Y + (size_t)(u.row0 + r) * DM + col0) = w; }
    }
};
struct Args { const float* in[26]; float* out; unsigned char* ws; int ph_lo, ph_hi, flags, pad; };
struct Frame {
    LAS unsigned char* lds;
    gu32* ctl;
    int tid, lane, wave, G, bid;
    float* out; unsigned char* ws;
};
#define KARG_PTR(off) (*(const float* const volatile __attribute__((address_space(4)))*)((const __attribute__((address_space(4))) char*)__builtin_amdgcn_kernarg_segment_ptr() + (off)))
#define AIN(i) KARG_PTR(8 * (i))
enum { I_X = 0, I_C, I_POS, I_WADA, I_BADA, I_N1W, I_WIN, I_QLNW, I_WUQ, I_KVLNW, I_WUKV, I_QNW, I_KNW, I_LBF, I_LBB, I_RNW, I_WOUT, I_N2W, I_WRT, I_RBIAS, I_WEG, I_WEU, I_WED, I_WSG, I_WSU, I_WSD };

template <bool F8 = false> __device__ __forceinline__ void conv_item64(const float* W, int N, bf16_t* WT, int ldk, int dst_row0, const float* kscale, int k0, int n0, int lane, float wscale = 1.0f) {
    const int n4 = (lane & 15) * 4, kg = lane >> 4;
    f32x4 v[2][8];
#pragma unroll
    for (int r = 0; r < 2; ++r)
#pragma unroll
        for (int i = 0; i < 8; ++i) v[r][i] = *(const f32x4*)(W + (size_t)(k0 + 32 * r + 8 * kg + i) * N + n0 + n4);
#pragma unroll
    for (int r = 0; r < 2; ++r) { const int kb = k0 + 32 * r + 8 * kg;
        if (kscale) {
#pragma unroll
            for (int i = 0; i < 8; ++i) v[r][i] = v[r][i] * kscale[kb + i]; }
#pragma unroll
        for (int j = 0; j < 4; ++j) {
            if constexpr (F8) { u32x2 o; o.x = pk4_fp8(v[r][0][j] * wscale, v[r][1][j] * wscale, v[r][2][j] * wscale, v[r][3][j] * wscale); o.y = pk4_fp8(v[r][4][j] * wscale, v[r][5][j] * wscale, v[r][6][j] * wscale, v[r][7][j] * wscale);
                *(u32x2*)((unsigned char*)WT + (size_t)(dst_row0 + n4 + j) * ldk + kb) = o; }
            else { u32x4 o; o.x = cvt_pk_bf16(v[r][0][j], v[r][1][j]); o.y = cvt_pk_bf16(v[r][2][j], v[r][3][j]); o.z = cvt_pk_bf16(v[r][4][j], v[r][5][j]); o.w = cvt_pk_bf16(v[r][6][j], v[r][7][j]);
                *(u32x4*)(WT + (size_t)(dst_row0 + n4 + j) * ldk + kb) = o; } } }
}
__device__ __forceinline__ void p0_prologue(Frame& F, const Args& args) {
    if (F.bid < 192) {
        LAS float* cond = (LAS float*)F.lds;
        LAS float* red = (LAS float*)(F.lds + 65536);
        for (int i = F.tid; i < 8 * 2048; i += 512) { const int b = i >> 11, k = i & 2047; const float c = AIN(I_C)[i]; cond[k * 8 + b] = siluf_(c); }
        __syncthreads();
        const int col = F.bid * 64 + F.lane; const float* wp = AIN(I_WADA) + col;
        float acc[8];
#pragma unroll
        for (int b = 0; b < 8; ++b) acc[b] = 0.f;
        const int kb = F.wave * 256;
#pragma unroll 16
        for (int k = 0; k < 256; ++k) { const float wv = wp[(size_t)(kb + k) * 12288]; const f32x4 c0 = *(const LAS f32x4*)(cond + (kb + k) * 8), c1 = *(const LAS f32x4*)(cond + (kb + k) * 8 + 4);
            acc[0] += c0[0] * wv; acc[1] += c0[1] * wv; acc[2] += c0[2] * wv; acc[3] += c0[3] * wv; acc[4] += c1[0] * wv; acc[5] += c1[1] * wv; acc[6] += c1[2] * wv; acc[7] += c1[3] * wv; }
#pragma unroll
        for (int b = 0; b < 8; ++b) red[(F.wave * 8 + b) * 64 + F.lane] = acc[b];
        __syncthreads();
        { const int b = F.wave; float s = AIN(I_BADA)[col];
#pragma unroll
          for (int w = 0; w < 8; ++w) s += red[(w * 8 + b) * 64 + F.lane];
          ((float*)(F.ws + WS_MOD))[b * 12288 + col] = s; }
        __syncthreads();
    }
    { u32x4 z = {0u, 0u, 0u, 0u}; u32x4* p0 = (u32x4*)(F.ws + WS_WIN + (size_t)832 * (INPROJ_FP8 ? 2048 : 4096)); u32x4* p1 = (u32x4*)(F.ws + WS_WRT + (size_t)64 * 4096);
      for (int i = F.bid * 512 + F.tid; i < 49152; i += F.G * 512) { if (i < (INPROJ_FP8 ? 24576 : 49152)) p0[i] = z; p1[i] = z; } }
}
__device__ __forceinline__ unsigned pk4_fp8(float a, float b, float c, float d) { int w = 0; w = __builtin_amdgcn_cvt_pk_fp8_f32(a, b, w, false); w = __builtin_amdgcn_cvt_pk_fp8_f32(c, d, w, true); return (unsigned)w; }
struct CvI { const float* src; unsigned char* dst; const float* kscale; int N, ldk; float scale; int gu, n0l, bf; };
constexpr int CV_NEXP = 3 * 64 * 256 + 3 * 256;
constexpr int CV_IN = 16 * 186, CV_UQ = 4 * 48, CV_UKV = 2 * 64, CV_OUT = 16 * 64, CV_RT = 16 * 2, CV_NSMALL = CV_IN + CV_UQ + CV_UKV + CV_OUT + CV_RT;
__device__ __forceinline__ void cv_decode(int r, CvI& c, unsigned char* ws) {
    unsigned char* WGU8 = ws + WS_WGU; unsigned char* WDN8 = ws + WS_WDN;
    constexpr int I_EX = 64 * 256, I_SH = 256;
    c.kscale = nullptr; c.bf = 0; c.gu = 0; c.n0l = 0;
    if (r >= CV_NEXP) {
        r -= CV_NEXP;
        if (r < CV_IN) { const int kb = r / 186, n0 = (r % 186) * 32, row = n0 + (n0 >= 832 ? 192 : 0); c.src = AIN(I_WIN) + (size_t)(kb * 128) * INC + n0; c.N = INC;
#if INPROJ_FP8
            c.dst = ws + WS_WIN + (size_t)row * 2048 + kb * 128; c.ldk = 2048; c.scale = 32.0f;
#else
            c.dst = ws + WS_WIN + (size_t)row * 4096 + kb * 256; c.ldk = 4096; c.scale = 1.0f; c.bf = 1;
#endif
            return; } r -= CV_IN;
        if (r < CV_UQ) { const int kb = r / 48, n0 = (r % 48) * 32; c.src = AIN(I_WUQ) + (size_t)(kb * 128) * 1536 + n0; c.N = 1536; c.dst = ws + WS_WUQ + (size_t)n0 * 512 + kb * 128; c.ldk = 512; c.scale = 16.0f; c.kscale = AIN(I_QLNW) + kb * 128; return; } r -= CV_UQ;
        if (r < CV_UKV) { const int kb = r / 64, n0 = (r % 64) * 32; c.src = AIN(I_WUKV) + (size_t)(kb * 128) * 2048 + n0; c.N = 2048; c.dst = ws + WS_WUKV + (size_t)n0 * 512 + kb * 256; c.ldk = 512; c.scale = 1.0f; c.bf = 1; c.kscale = AIN(I_KVLNW) + kb * 128; return; } r -= CV_UKV;
        if (r < CV_OUT) { const int kb = r / 64, n0 = (r % 64) * 32; c.src = AIN(I_WOUT) + (size_t)(kb * 128) * 2048 + n0; c.N = 2048; c.dst = ws + WS_WOUT + (size_t)n0 * 2048 + kb * 128; c.ldk = 2048; c.scale = 32.0f; return; } r -= CV_OUT;
        { const int kb = r >> 1, n0 = (r & 1) * 32; c.src = AIN(I_WRT) + (size_t)(kb * 128) * 64 + n0; c.N = 64; c.dst = ws + WS_WRT + (size_t)n0 * 4096 + kb * 256; c.ldk = 4096; c.scale = 1.0f; c.bf = 1; return; }
    }
    int sel, e, q;
    if (r < 3 * I_EX) { sel = r / I_EX; const int rr = r - sel * I_EX; e = rr >> 8; q = rr & 255; } else { const int rr = r - 3 * I_EX; sel = rr / I_SH; q = rr - sel * I_SH; e = 64; }
    if (sel < 2) { const int kb = q >> 4, n0 = (q & 15) * 32; const float* W = (e < 64) ? ((sel == 0 ? AIN(I_WEG) : AIN(I_WEU)) + (size_t)e * 2048 * 512) : (sel == 0 ? AIN(I_WSG) : AIN(I_WSU));
        c.src = W + (size_t)(kb * 128) * 512 + n0; c.N = 512; c.ldk = 2048; c.scale = 32.0f;
        c.dst = WGU8 + (size_t)e * 1024 * 2048 + (size_t)((n0 >> 7) * 256 + sel * 8) * 2048 + kb * 128; c.gu = 1; c.n0l = n0 & 127; }
    else { const int kb = q >> 6, n0 = (q & 63) * 32; const float* W = (e < 64) ? (AIN(I_WED) + (size_t)e * 512 * 2048) : AIN(I_WSD);
        c.src = W + (size_t)(kb * 128) * 2048 + n0; c.N = 2048; c.ldk = 512; c.scale = 16.0f;
        c.dst = WDN8 + (size_t)e * 2048 * 512 + (size_t)n0 * 512 + kb * 128; }
}
__device__ __forceinline__ void cv_load(const CvI& c, int lane, f32x4 (&v)[16]) {
    const float* p = c.src + (size_t)(16 * (lane >> 3)) * c.N + (lane & 7) * 4;
#pragma unroll
    for (int i = 0; i < 16; ++i) v[i] = *(const f32x4*)(p + (size_t)i * c.N);
}
__device__ __forceinline__ void cv_store(const CvI& c, int lane, f32x4 (&v)[16]) {
    const int n4 = (lane & 7) * 4, al = c.n0l + n4, kg = lane >> 3;
    const size_t row = (size_t)(c.gu ? (2 * (al & ~7) + (al & 7)) : n4); const float s = c.scale;
    if (c.kscale) {
#pragma unroll
        for (int i = 0; i < 16; ++i) v[i] = v[i] * c.kscale[16 * kg + i]; }
    if (c.bf) { unsigned char* p = c.dst + row * c.ldk + 32 * kg;
#pragma unroll
        for (int j = 0; j < 4; ++j) { u32x4 o0, o1;
            o0.x = cvt_pk_bf16(v[0][j], v[1][j]); o0.y = cvt_pk_bf16(v[2][j], v[3][j]); o0.z = cvt_pk_bf16(v[4][j], v[5][j]); o0.w = cvt_pk_bf16(v[6][j], v[7][j]);
            o1.x = cvt_pk_bf16(v[8][j], v[9][j]); o1.y = cvt_pk_bf16(v[10][j], v[11][j]); o1.z = cvt_pk_bf16(v[12][j], v[13][j]); o1.w = cvt_pk_bf16(v[14][j], v[15][j]);
            *(u32x4*)(p + (size_t)j * c.ldk) = o0; *(u32x4*)(p + (size_t)j * c.ldk + 16) = o1; }
        return; }
    unsigned char* p = c.dst + row * c.ldk + 16 * kg;
#pragma unroll
    for (int j = 0; j < 4; ++j) { u32x4 o;
        o.x = pk4_fp8(v[0][j] * s, v[1][j] * s, v[2][j] * s, v[3][j] * s); o.y = pk4_fp8(v[4][j] * s, v[5][j] * s, v[6][j] * s, v[7][j] * s);
        o.z = pk4_fp8(v[8][j] * s, v[9][j] * s, v[10][j] * s, v[11][j] * s); o.w = pk4_fp8(v[12][j] * s, v[13][j] * s, v[14][j] * s, v[15][j] * s);
        *(u32x4*)(p + (size_t)j * c.ldk) = o; }
}
__device__ __forceinline__ void convert_experts(Frame& F, const Args& args, int b0, int nblk) {
    const int gw = (F.bid - b0) * NWAVES + F.wave, NGW = nblk * NWAVES;
    constexpr int NITEMS = CV_NEXP + CV_NSMALL;
    CvI A, B; f32x4 va[16], vb[16];
    int it = gw; if (it >= NITEMS) return;
    cv_decode(it, A, F.ws); cv_load(A, F.lane, va);
    for (;;) {
        const int itn = it + NGW; const bool hasn = itn < NITEMS;
        if (hasn) { cv_decode(itn, B, F.ws); cv_load(B, F.lane, vb); }
        cv_store(A, F.lane, va);
        if (!hasn) break;
        it = itn + NGW; const bool has2 = it < NITEMS;
        if (has2) { cv_decode(it, A, F.ws); cv_load(A, F.lane, va); }
        cv_store(B, F.lane, vb);
        if (!has2) break;
    }
}

template <bool ADD, bool OUT16, bool OUT8, bool SUM16 = false> __device__ __forceinline__ void rms_mod_rows(Frame& F, const Args& args, const float* src, const bf16_t* add, const float* nw, int sh_off, int sc_off, bf16_t* dst, unsigned char* dst8) {
    const int gw = F.bid * NWAVES + F.wave, NGW = F.G * NWAVES;
    const float* mod = (const float*)(F.ws + WS_MOD);
    for (int g0 = gw * 8; g0 < T; g0 += NGW * 8) {
        const int b = g0 >> 11;
        f32x4 a[8], sh[8];
#pragma unroll
        for (int j = 0; j < 8; ++j) { const int c = j * 256 + F.lane * 4; const f32x4 w = *(const f32x4*)(nw + c), s = *(const f32x4*)(mod + b * 12288 + sc_off + c); a[j] = w * (s + 1.0f); sh[j] = *(const f32x4*)(mod + b * 12288 + sh_off + c); }
        f32x4 nx[8]; u32x2 na[8];
        { const f32x4* xr = (const f32x4*)(src + (size_t)g0 * DM) + F.lane; const u32x2* ar = (const u32x2*)(add + (size_t)g0 * DM) + F.lane;
#pragma unroll
          for (int j = 0; j < 8; ++j) { nx[j] = xr[64 * j]; if (ADD) na[j] = ar[64 * j]; } }
        for (int m = g0; m < g0 + 8; ++m) {
            f32x4 v[8]; float s = 0.f;
#pragma unroll
            for (int j = 0; j < 8; ++j) { v[j] = nx[j]; if (ADD) { v[j].x += bf_lo(na[j].x); v[j].y += bf_hi(na[j].x); v[j].z += bf_lo(na[j].y); v[j].w += bf_hi(na[j].y); } }
            if (m + 1 < g0 + 8) { const f32x4* xr = (const f32x4*)(src + (size_t)(m + 1) * DM) + F.lane; const u32x2* ar = (const u32x2*)(add + (size_t)(m + 1) * DM) + F.lane;
#pragma unroll
                for (int j = 0; j < 8; ++j) { nx[j] = xr[64 * j]; if (ADD) na[j] = ar[64 * j]; } }
#pragma unroll
            for (int j = 0; j < 8; ++j) s += (v[j].x * v[j].x + v[j].y * v[j].y) + (v[j].z * v[j].z + v[j].w * v[j].w);
            if (SUM16) { u32x2* sr = (u32x2*)(const_cast<bf16_t*>(add) + (size_t)m * DM) + F.lane;
#pragma unroll
                for (int j = 0; j < 8; ++j) { u32x2 w; w.x = cvt_pk_bf16(v[j].x, v[j].y); w.y = cvt_pk_bf16(v[j].z, v[j].w); sr[64 * j] = w; } }
            const float rstd = __builtin_amdgcn_rsqf(wave_sum(s) * (1.f / DM) + EPS);
            u32x2* o8 = (u32x2*)(dst + (size_t)m * DM) + F.lane; unsigned* o4 = (unsigned*)(dst8 + (size_t)m * DM) + F.lane;
#pragma unroll
            for (int j = 0; j < 8; ++j) { const f32x4 y = v[j] * rstd * a[j] + sh[j];
                if (OUT16) { u32x2 w; w.x = cvt_pk_bf16(y.x, y.y); w.y = cvt_pk_bf16(y.z, y.w); o8[64 * j] = w; }
                if (OUT8) o4[64 * j] = pk4_fp8(y.x, y.y, y.z, y.w); }
        }
    }
}

__device__ __forceinline__ void add_fp8x8(const u32x2 w, float (&acc)[8]) {
    f32x2 p;
    p = __builtin_amdgcn_cvt_pk_f32_fp8((int)w.x, false); acc[0] += p.x; acc[1] += p.y; p = __builtin_amdgcn_cvt_pk_f32_fp8((int)w.x, true); acc[2] += p.x; acc[3] += p.y;
    p = __builtin_amdgcn_cvt_pk_f32_fp8((int)w.y, false); acc[4] += p.x; acc[5] += p.y; p = __builtin_amdgcn_cvt_pk_f32_fp8((int)w.y, true); acc[6] += p.x; acc[7] += p.y;
}
__device__ __forceinline__ void unpack8(const u32x4 w, float (&f)[8]) { f[0] = bf_lo(w.x); f[1] = bf_hi(w.x); f[2] = bf_lo(w.y); f[3] = bf_hi(w.y); f[4] = bf_lo(w.z); f[5] = bf_hi(w.z); f[6] = bf_lo(w.w); f[7] = bf_hi(w.w); }
__device__ __forceinline__ u32x4 pack8(const float* f) { u32x4 w; w.x = cvt_pk_bf16(f[0], f[1]); w.y = cvt_pk_bf16(f[2], f[3]); w.z = cvt_pk_bf16(f[4], f[5]); w.w = cvt_pk_bf16(f[6], f[7]); return w; }
__device__ __forceinline__ void ld8f(const LAS float* p, float (&f)[8]) { const f32x4 a = *(const LAS f32x4*)p, b = *(const LAS f32x4*)(p + 4); f[0] = a[0]; f[1] = a[1]; f[2] = a[2]; f[3] = a[3]; f[4] = b[0]; f[5] = b[1]; f[6] = b[2]; f[7] = b[3]; }
__device__ __forceinline__ u32x2 pack8_fp8(const float* f) { u32x2 w; w.x = pk4_fp8(f[0], f[1], f[2], f[3]); w.y = pk4_fp8(f[4], f[5], f[6], f[7]); return w; }
__device__ __forceinline__ void head_norm_rope_store(const LAS float* scr, const LAS float* cs, const LAS float* sn, const LAS float* nw, float oscale, unsigned char* dst, int lane) {
    const int head = lane >> 3, part = lane & 7; const LAS float* hv = scr + head * 192;
    float x0[8], x1[8], x2[8], xp[8];
    ld8f(hv + 8 * part, x0); ld8f(hv + 64 + 8 * part, x1); ld8f(hv + 128 + 8 * part, x2);
    const bool first = part < 4; const int pofs = first ? (160 + 8 * part) : (96 + 8 * part);
    ld8f(hv + pofs, xp);
    float ss = 0.f;
#pragma unroll
    for (int e = 0; e < 8; ++e) ss += x0[e] * x0[e] + x1[e] * x1[e] + x2[e] * x2[e];
    ss += __shfl_xor(ss, 1); ss += __shfl_xor(ss, 2); ss += __shfl_xor(ss, 4);
    const float r = __builtin_amdgcn_rsqf(ss * (1.f / 192.f) + EPS) * oscale;
    float w[8], o[8];
    ld8f(nw + 8 * part, w);
#pragma unroll
    for (int e = 0; e < 8; ++e) o[e] = x0[e] * w[e] * r;
    *(u32x2*)(dst + 8 * part) = pack8_fp8(o);
    ld8f(nw + 64 + 8 * part, w);
#pragma unroll
    for (int e = 0; e < 8; ++e) o[e] = x1[e] * w[e] * r;
    *(u32x2*)(dst + 64 + 8 * part) = pack8_fp8(o);
    float wp[8], c[8], sv[8];
    ld8f(nw + 128 + 8 * part, w); ld8f(nw + pofs, wp); ld8f(cs + 8 * (part & 3), c); ld8f(sn + 8 * (part & 3), sv);
#pragma unroll
    for (int e = 0; e < 8; ++e) { const float own = x2[e] * w[e], oth = xp[e] * wp[e];
        o[e] = (first ? (own * c[e] - oth * sv[e]) : (oth * sv[e] + own * c[e])) * r; }
    *(u32x2*)(dst + 128 + 8 * part) = pack8_fp8(o);
}
__device__ __forceinline__ void finalize_qkv(Frame& F, const Args& args) {
    LAS float* scr = (LAS float*)(F.lds + F.wave * 12288); LAS float* cs = scr + 2048; LAS float* sn = cs + 32;
    LAS float* qnw = (LAS float*)(F.lds + 8 * 12288); LAS float* knw = qnw + 192;
    if (F.tid < 192) qnw[F.tid] = AIN(I_QNW)[F.tid]; else if (F.tid < 384) knw[F.tid - 192] = AIN(I_KNW)[F.tid - 192];
    __syncthreads();
    const int gw = F.bid * NWAVES + F.wave, NGW = F.G * NWAVES, lane = F.lane;
    const bf16_t* QLAT = (const bf16_t*)(F.ws + WS_QLAT); const bf16_t* KVLAT = (const bf16_t*)(F.ws + WS_KVLAT); const bf16_t* KROPE = (const bf16_t*)(F.ws + WS_KROPE);
    const bf16_t* QRAW = (const bf16_t*)(F.ws + WS_QRAW); const bf16_t* KVRAW = (const bf16_t*)(F.ws + WS_KVRAW);
    unsigned char* Q = F.ws + WS_Q; unsigned char* K = F.ws + WS_K; bf16_t* V = (bf16_t*)(F.ws + WS_V);
    const float qscale = 0.07216878364870322f * 1.4426950408889634f;
    const float inv = __builtin_amdgcn_exp2f(-(float)(2 * (lane & 31)) * (13.287712379549449f / 64.f));
    u32x4 n_kvl, n_qr[3], n_kvr[4], n_kr; u32x2 n_ql8; int n_pos;
#define FQ_LOAD(tok) do { n_ql8 = *(const u32x2*)((const unsigned char*)QLAT + (size_t)(tok) * 512 + lane * 8); n_kvl = *(const u32x4*)(KVLAT + (size_t)(tok) * 256 + (lane & 31) * 8); n_kr = *(const u32x4*)(KROPE + (size_t)(tok) * 64 + (lane & 7) * 8); \
        n_pos = ((const int*)AIN(I_POS))[tok]; _Pragma("unroll") for (int j = 0; j < 3; ++j) n_qr[j] = *(const u32x4*)(QRAW + (size_t)(tok) * 1536 + (j * 64 + lane) * 8); \
        _Pragma("unroll") for (int j = 0; j < 4; ++j) n_kvr[j] = *(const u32x4*)(KVRAW + (size_t)(tok) * 2048 + (j * 64 + lane) * 8); } while (0)
    if (gw < T) FQ_LOAD(gw);
    for (int tok = gw; tok < T; tok += NGW) {
        const u32x4 c_kvl = n_kvl, c_kr = n_kr; const u32x2 c_ql8 = n_ql8; const int pos = n_pos; u32x4 c_qr[3], c_kvr[4];
#pragma unroll
        for (int j = 0; j < 3; ++j) c_qr[j] = n_qr[j];
#pragma unroll
        for (int j = 0; j < 4; ++j) c_kvr[j] = n_kvr[j];
        if (tok + NGW < T) FQ_LOAD(tok + NGW);
        const int b = tok >> 11, s = tok & 2047;
        if (lane < 32) { const float ang = (float)pos * inv;
            const float kq = rintf(ang * 0.15915494309189535f); float rr = fmaf(-kq, 6.2831854820251465f, ang); rr = fmaf(-kq, -1.7484555e-7f, rr);
            const float rev = rr * 0.15915494309189535f;
            cs[lane] = __builtin_amdgcn_cosf(rev); sn[lane] = __builtin_amdgcn_sinf(rev); }
        float f[8];
#pragma unroll
        for (int e = 0; e < 8; ++e) f[e] = 0.f;
        add_fp8x8(c_ql8, f); float sq = 0.f;
#pragma unroll
        for (int e = 0; e < 8; ++e) sq += f[e] * f[e];
        const float rstd_q = __builtin_amdgcn_rsqf(wave_sum(sq) * (1.f / 512.f) + EPS);
        float sk = 0.f;
        if (lane < 32) { unpack8(c_kvl, f);
#pragma unroll
            for (int e = 0; e < 8; ++e) sk += f[e] * f[e]; }
        const float rstd_kv = __builtin_amdgcn_rsqf(wave_sum(sk) * (1.f / 256.f) + EPS);
#pragma unroll
        for (int j = 0; j < 3; ++j) { const int ci = j * 64 + lane; unpack8(c_qr[j], f);
            *(LAS f32x4*)(scr + ci * 8) = (f32x4){f[0], f[1], f[2], f[3]} * rstd_q; *(LAS f32x4*)(scr + ci * 8 + 4) = (f32x4){f[4], f[5], f[6], f[7]} * rstd_q; }
        LDS_WAIT(); asm volatile("" ::: "memory");
        head_norm_rope_store(scr, cs, sn, qnw, qscale, Q + ((size_t)(b * NH + (lane >> 3)) * SEQ + s) * DQK, lane);
        LDS_WAIT(); asm volatile("" ::: "memory");
#pragma unroll
        for (int j = 0; j < 4; ++j) { const int ci = j * 64 + lane; const int head = ci >> 5, within = (ci & 31) * 8; unpack8(c_kvr[j], f);
#pragma unroll
            for (int e = 0; e < 8; ++e) f[e] *= rstd_kv;
            if (within < 128) { *(LAS f32x4*)(scr + head * 192 + within) = (f32x4){f[0], f[1], f[2], f[3]}; *(LAS f32x4*)(scr + head * 192 + within + 4) = (f32x4){f[4], f[5], f[6], f[7]}; }
            else *(u32x4*)(V + ((size_t)(b * NH + head) * SEQ + s) * DV + (within - 128)) = pack8(f); }
        if (lane < 8) { unpack8(c_kr, f);
#pragma unroll
            for (int h = 0; h < 8; ++h) { *(LAS f32x4*)(scr + h * 192 + 128 + lane * 8) = (f32x4){f[0], f[1], f[2], f[3]}; *(LAS f32x4*)(scr + h * 192 + 128 + lane * 8 + 4) = (f32x4){f[4], f[5], f[6], f[7]}; } }
        LDS_WAIT(); asm volatile("" ::: "memory");
        head_norm_rope_store(scr, cs, sn, knw, 1.0f, K + ((size_t)(b * NH + (lane >> 3)) * SEQ + s) * DQK, lane);
        LDS_WAIT(); asm volatile("" ::: "memory");
    }
#undef FQ_LOAD
}

__device__ __forceinline__ void rec_chunk32(Frame& F, const Args& args, int tok0) {
    const int lane = F.lane;
    const bf16_t* OFp = (const bf16_t*)(F.ws + WS_OF); const bf16_t* OBp = (const bf16_t*)(F.ws + WS_OB); const bf16_t* RG = (const bf16_t*)(F.ws + WS_RG); unsigned char* CAT = F.ws + WS_CAT;
    u32x4 n[4][6];
#pragma unroll
    for (int i = 0; i < 4; ++i) { const size_t o = (size_t)(tok0 + F.wave * 4 + i) * 1024 + lane * 16;
        n[i][0] = *(const u32x4*)(OFp + o); n[i][1] = *(const u32x4*)(OFp + o + 8); n[i][2] = *(const u32x4*)(OBp + o); n[i][3] = *(const u32x4*)(OBp + o + 8); n[i][4] = *(const u32x4*)(RG + o); n[i][5] = *(const u32x4*)(RG + o + 8); }
    float nw[16];
#pragma unroll
    for (int e = 0; e < 16; ++e) nw[e] = AIN(I_RNW)[(lane & 7) * 16 + e];
#pragma unroll
    for (int i = 0; i < 4; ++i) {
        float a[16], bb[16], g[16];
        unpack8(n[i][0], *(float(*)[8])a); unpack8(n[i][1], *(float(*)[8])(a + 8));
        unpack8(n[i][2], *(float(*)[8])bb); unpack8(n[i][3], *(float(*)[8])(bb + 8));
        unpack8(n[i][4], *(float(*)[8])g); unpack8(n[i][5], *(float(*)[8])(g + 8));
        float ss = 0.f;
#pragma unroll
        for (int e = 0; e < 16; ++e) { a[e] += bb[e]; ss += a[e] * a[e]; }
        ss += __shfl_xor(ss, 1); ss += __shfl_xor(ss, 2); ss += __shfl_xor(ss, 4);
        const float r = __builtin_amdgcn_rsqf(ss * (1.f / 128.f) + EPS);
#pragma unroll
        for (int e = 0; e < 16; ++e) a[e] = a[e] * r * nw[e] * siluf_(g[e]);
        u32x4 w8; w8.x = pk4_fp8(a[0], a[1], a[2], a[3]); w8.y = pk4_fp8(a[4], a[5], a[6], a[7]); w8.z = pk4_fp8(a[8], a[9], a[10], a[11]); w8.w = pk4_fp8(a[12], a[13], a[14], a[15]);
        *(u32x4*)(CAT + (size_t)(tok0 + F.wave * 4 + i) * 2048 + 1024 + lane * 16) = w8;
    }
}

__device__ __forceinline__ float wave_max_dpp(float v) {
#define WM_STEP(ctrl) v = fmaxf(v, __int_as_float(__builtin_amdgcn_update_dpp(__float_as_int(v), __float_as_int(v), ctrl, 0xF, 0xF, false)))
    WM_STEP(0xB1); WM_STEP(0x4E); WM_STEP(0x141); WM_STEP(0x140);
#undef WM_STEP
    const float r0 = __int_as_float(__builtin_amdgcn_readlane(__float_as_int(v), 0)), r1 = __int_as_float(__builtin_amdgcn_readlane(__float_as_int(v), 16));
    const float r2 = __int_as_float(__builtin_amdgcn_readlane(__float_as_int(v), 32)), r3 = __int_as_float(__builtin_amdgcn_readlane(__float_as_int(v), 48));
    return fmaxf(fmaxf(r0, r1), fmaxf(r2, r3));
}
__device__ __forceinline__ float wave_sum_dpp(float v) {
#define WS_STEP(ctrl) v += __int_as_float(__builtin_amdgcn_update_dpp(0, __float_as_int(v), ctrl, 0xF, 0xF, false))
    WS_STEP(0xB1); WS_STEP(0x4E); WS_STEP(0x141); WS_STEP(0x140);
#undef WS_STEP
    const float r0 = __int_as_float(__builtin_amdgcn_readlane(__float_as_int(v), 0)), r1 = __int_as_float(__builtin_amdgcn_readlane(__float_as_int(v), 16));
    const float r2 = __int_as_float(__builtin_amdgcn_readlane(__float_as_int(v), 32)), r3 = __int_as_float(__builtin_amdgcn_readlane(__float_as_int(v), 48));
    return (r0 + r1) + (r2 + r3);
}
__device__ __forceinline__ float grp8_max_dpp(float v) {
#define WM_STEP(ctrl) v = fmaxf(v, __int_as_float(__builtin_amdgcn_update_dpp(__float_as_int(v), __float_as_int(v), ctrl, 0xF, 0xF, false)))
    WM_STEP(0xB1); WM_STEP(0x4E); WM_STEP(0x141);
#undef WM_STEP
    return v;
}
__device__ __forceinline__ void route_topk(Frame& F, const Args& args) {
    const int gw = F.bid * NWAVES + F.wave, NGW = F.G * NWAVES, lane = F.lane;
    const float* logit = (const float*)(F.ws + WS_LOGIT); int* elist = (int*)(F.ws + WS_ELIST); int* slot_ep = (int*)(F.ws + WS_SLOTEP); float* slot_w = (float*)(F.ws + WS_SLOTW);
    const float bias = AIN(I_RBIAS)[lane]; const int g = lane >> 3;
    const float NEG = -__builtin_inff();
    LAS unsigned* hist = (LAS unsigned*)F.lds; LAS unsigned* hbase = hist + 64;
    for (int tok0 = gw; tok0 < T; tok0 += 8 * NGW) {
        if (F.tid < 64) hist[F.tid] = 0u;
        __syncthreads();
        float wv[8]; int erv[8]; unsigned lpv[8]; float lg[8];
#pragma unroll
        for (int i = 0; i < 8; ++i) { const int tok = tok0 + i * NGW; const size_t li = (size_t)(tok < T ? tok : 0) * 64 + lane;
            lg[i] = (logit[li] + logit[li + (size_t)T * 64]) + (logit[li + (size_t)2 * T * 64] + logit[li + (size_t)3 * T * 64]); }
#pragma unroll 1
        for (int i = 0; i < 8; ++i) { const int tok = tok0 + i * NGW; float w_ = 0.f; int er_ = -1; unsigned lp_ = 0u;
          float lgi = lg[0];
#pragma unroll
          for (int q = 1; q < 8; ++q) lgi = (q == i) ? lg[q] : lgi;
          if (tok < T) {
            float sc = sigmoidf_(lgi); sc = (sc == sc) ? sc : 0.5f;
            const float sel = sc + bias;
            const float m1 = grp8_max_dpp(sel);
            const unsigned long long bal = __ballot(sel == m1) & (0xFFull << (8 * g)); const int first = __builtin_ctzll(bal);
            const float m2 = grp8_max_dpp((lane == first) ? NEG : sel);
            const float gs = m1 + m2; int grank = 0;
#pragma unroll
            for (int j = 0; j < 8; ++j) { const float v = __int_as_float(__builtin_amdgcn_readlane(__float_as_int(gs), 8 * j)); grank += (v > gs || (v == gs && j < g)) ? 1 : 0; }
            const bool chosen = grank < TOPG; float rem = chosen ? sel : NEG; int er = TOPK;
#pragma unroll
            for (int k = 0; k < TOPK; ++k) { const float m = wave_max_dpp(rem); const int pick = __builtin_ctzll(__ballot(rem == m)); if (lane == pick) { er = k; rem = NEG; } }
            const bool selected = er < TOPK;
            const float sumw = wave_sum_dpp(selected ? sc : 0.f); w_ = sc / sumw * ROUTED_SCALE;
            if (selected) { er_ = er; lp_ = __hip_atomic_fetch_add(hist + lane, 1u, __ATOMIC_RELAXED, __HIP_MEMORY_SCOPE_WORKGROUP); }
            if (lane == 0) elist[(size_t)64 * 16384 + tok] = tok * 8;
          }
#pragma unroll
          for (int q = 0; q < 8; ++q) if (q == i) { wv[q] = w_; erv[q] = er_; lpv[q] = lp_; }
        }
        __syncthreads();
        if (F.tid < 64) { const unsigned c = hist[F.tid]; hbase[F.tid] = c ? __hip_atomic_fetch_add((unsigned*)(F.ctl + CW_CNT + 64 * F.tid), c, RLX_AGENT) : 0u; }
        __syncthreads();
        const unsigned base = hbase[lane];
#pragma unroll
        for (int i = 0; i < 8; ++i) { const int tok = tok0 + i * NGW;
            if (erv[i] >= 0) { const unsigned pos = base + lpv[i]; elist[(size_t)lane * 16384 + pos] = tok * 8 + erv[i]; slot_ep[tok * 8 + erv[i]] = (lane << 16) | (int)pos; slot_w[tok * 8 + erv[i]] = wv[i]; } }
        __syncthreads();
    }
}

__device__ __forceinline__ void moe_combine(Frame& F, const Args& args) {
    const int gw = F.bid * NWAVES + F.wave, NGW = F.G * NWAVES, lane = F.lane;
    const unsigned char* Y = (const unsigned char*)(F.ws + WS_Y); const float* mod = (const float*)(F.ws + WS_MOD);
    const int* slot_ep = (const int*)(F.ws + WS_SLOTEP); const float* slot_w = (const float*)(F.ws + WS_SLOTW); const bf16_t* Y1 = (const bf16_t*)(F.ws + WS_Y1);
    const LAS int* ro = (const LAS int*)(F.lds + GTAB_OFF) + 132;
    const int sh0 = ro[64];
    for (int tok = gw; tok < T; tok += NGW) {
        const int b = tok >> 11;
        int myrow = 0; float myw = 0.f;
        if (lane < 8) { const int ep = slot_ep[tok * 8 + lane]; myrow = ro[ep >> 16] + (ep & 0xffff); myw = slot_w[tok * 8 + lane]; }
        int rows[8]; float wk[8];
#pragma unroll
        for (int k = 0; k < 8; ++k) { rows[k] = __shfl(myrow, k); wk[k] = __shfl(myw, k); }
#pragma unroll
        for (int j = 0; j < 4; ++j) { const int col = j * 512 + lane * 8; float acc[8];
#pragma unroll
            for (int e = 0; e < 8; ++e) acc[e] = 0.f;
            u32x2 yv[9];
            yv[8] = *(const u32x2*)(Y + (size_t)(sh0 + tok) * DM + col);
#pragma unroll
            for (int k = 0; k < 8; ++k) yv[k] = *(const u32x2*)(Y + (size_t)rows[k] * DM + col);
#pragma unroll
            for (int k = 0; k < 8; ++k) { float t8[8];
#pragma unroll
                for (int e = 0; e < 8; ++e) t8[e] = 0.f;
                add_fp8x8(yv[k], t8);
#pragma unroll
                for (int e = 0; e < 8; ++e) acc[e] += wk[k] * t8[e]; }
            add_fp8x8(yv[8], acc);
            float* op = F.out + (size_t)tok * DM + col; const float* gp = mod + b * 12288 + 10240 + col;
            const u32x4 yw = *(const u32x4*)(Y1 + (size_t)tok * DM + col);
            const f32x4 g0 = *(const f32x4*)gp, g1 = *(const f32x4*)(gp + 4);
            *(f32x4*)op = (f32x4){bf_lo(yw.x), bf_hi(yw.x), bf_lo(yw.y), bf_hi(yw.y)} + g0 * (f32x4){acc[0], acc[1], acc[2], acc[3]};
            *(f32x4*)(op + 4) = (f32x4){bf_lo(yw.z), bf_hi(yw.z), bf_lo(yw.w), bf_hi(yw.w)} + g1 * (f32x4){acc[4], acc[5], acc[6], acc[7]}; }
    }
}
namespace att {
constexpr int KT_BYTES = 64 * 192, VT_BYTES = 64 * 256;
constexpr int L_K = 0, L_V = 2 * KT_BYTES, L_WS = L_V + 2 * VT_BYTES, L_END = L_WS + 8 * 256;
constexpr float THR = 8.f * 1.4426950408889634f;
#define ATT_SBAR() __builtin_amdgcn_sched_barrier(0)
__device__ __forceinline__ int crow(int r, int hi) { return (r & 3) + 8 * (r >> 2) + 4 * hi; }
__device__ __forceinline__ int kswz(int row, int chunk) { return row * 192 + (((chunk & ~3) | ((chunk & 3) ^ ((row >> 2) & 3))) << 4); }
typedef int v8i_a __attribute__((ext_vector_type(8)));
__device__ __forceinline__ void partialSM(f32x16& p0, f32x16& p1, float& m_reg, float& mn, float& alpha) {
    float pmax = fmaxf(p0[0], p1[0]);
#pragma unroll
    for (int r = 1; r < 16; r += 2) pmax = __builtin_fmaxf(__builtin_fmaxf(pmax, p0[r]), p0[r + 1 < 16 ? r + 1 : r]);
#pragma unroll
    for (int r = 1; r < 16; r += 2) pmax = __builtin_fmaxf(__builtin_fmaxf(pmax, p1[r]), p1[r + 1 < 16 ? r + 1 : r]);
    { auto rr = __builtin_amdgcn_permlane32_swap(__float_as_uint(pmax), __float_as_uint(pmax), false, false); pmax = fmaxf(__uint_as_float(rr[0]), __uint_as_float(rr[1])); }
    if (__builtin_expect(__all(pmax <= THR), 1)) { mn = 0.f; alpha = 1.f;
#pragma unroll
        for (int r = 0; r < 16; ++r) p0[r] = __builtin_amdgcn_exp2f(p0[r]);
    } else { mn = fmaxf(pmax, 0.f); alpha = __builtin_amdgcn_exp2f(-mn); m_reg += mn;
#pragma unroll
        for (int r = 0; r < 16; ++r) p0[r] = __builtin_amdgcn_exp2f(p0[r] - mn);
    }
}
__device__ __forceinline__ void finishSM(f32x16& p0, f32x16& p1, float mn, float alpha, float& l_reg, bf16x8& pa0, bf16x8& pa1, bf16x8& pa2, bf16x8& pa3) {
    if (__builtin_expect(__all(mn == 0.f), 1)) {
#pragma unroll
        for (int r = 0; r < 16; ++r) p1[r] = __builtin_amdgcn_exp2f(p1[r]);
    } else {
#pragma unroll
        for (int r = 0; r < 16; ++r) p1[r] = __builtin_amdgcn_exp2f(p1[r] - mn);
    }
    float ps = 0;
#pragma unroll
    for (int r = 0; r < 16; ++r) ps += p0[r];
#pragma unroll
    for (int r = 0; r < 16; ++r) ps += p1[r];
    { auto rr = __builtin_amdgcn_permlane32_swap(__float_as_uint(ps), __float_as_uint(ps), false, false); ps = __uint_as_float(rr[0]) + __uint_as_float(rr[1]); }
    l_reg = l_reg * alpha + ps;
#define ATT_PK4(P, BASE, OUT) do { unsigned a0 = cvt_pk_bf16(P[BASE + 0], P[BASE + 1]), a1 = cvt_pk_bf16(P[BASE + 2], P[BASE + 3]);   \
    unsigned b0 = cvt_pk_bf16(P[BASE + 4], P[BASE + 5]), b1 = cvt_pk_bf16(P[BASE + 6], P[BASE + 7]);                              \
    auto r0 = __builtin_amdgcn_permlane32_swap(a0, b0, false, false); auto r1 = __builtin_amdgcn_permlane32_swap(a1, b1, false, false); \
    u32x4 w = {r0[0], r1[0], r0[1], r1[1]}; OUT = *reinterpret_cast<bf16x8*>(&w); } while (0)
    ATT_PK4(p0, 0, pa0); ATT_PK4(p0, 8, pa1); ATT_PK4(p1, 0, pa2); ATT_PK4(p1, 8, pa3);
#undef ATT_PK4
}
__device__ __forceinline__ v8i_a ld32(const char* p0, const char* p1) { const u32x4 lo = *reinterpret_cast<const u32x4*>(p0), hi = *reinterpret_cast<const u32x4*>(p1); return (v8i_a){(int)lo.x, (int)lo.y, (int)lo.z, (int)lo.w, (int)hi.x, (int)hi.y, (int)hi.z, (int)hi.w}; }
__device__ __forceinline__ void qkt(f32x16& p0, f32x16& p1, const char* Ks, const v8i_a* qr, int r32, int hi, float m_reg) {
    const float c0 = -m_reg;
#pragma unroll
    for (int r = 0; r < 16; ++r) { p0[r] = c0; p1[r] = c0; }
#pragma unroll
    for (int s = 0; s < 3; ++s) { const int ch = 4 * s + 2 * hi;
        const v8i_a a0 = ld32(Ks + kswz(r32, ch), Ks + kswz(r32, ch + 1)), a1 = ld32(Ks + kswz(32 + r32, ch), Ks + kswz(32 + r32, ch + 1));
        p0 = __builtin_amdgcn_mfma_scale_f32_32x32x64_f8f6f4(a0, qr[s], p0, 0, 0, 0, 0, 0, 0);
        p1 = __builtin_amdgcn_mfma_scale_f32_32x32x64_f8f6f4(a1, qr[s], p1, 0, 0, 0, 0, 0, 0); }
}
__device__ __forceinline__ int v_rd_base(int lane) { return ((lane & 3) << 3) | (((lane >> 2) & 3) << 6) | (((lane >> 4) & 1) << 5) | (((lane >> 5) & 1) << 8); }
constexpr int v_rd_off(int d0, int ks, int half) { return d0 * 512 + ks * 4096 + half * 2048; }
template <int OFF> __device__ __forceinline__ s16x4 tr_read(int vb) { s16x4 r; asm volatile("ds_read_b64_tr_b16 %0, %1 offset:%2" : "=&v"(r) : "v"(vb), "i"(OFF) : "memory"); return r; }
template <int D0> __device__ __forceinline__ void pv_one(f32x16& od, int vb, bf16x8 pa0, bf16x8 pa1, bf16x8 pa2, bf16x8 pa3) {
    const s16x4 l0 = tr_read<v_rd_off(D0, 0, 0)>(vb), h0 = tr_read<v_rd_off(D0, 0, 1)>(vb), l1 = tr_read<v_rd_off(D0, 1, 0)>(vb), h1 = tr_read<v_rd_off(D0, 1, 1)>(vb);
    const s16x4 l2 = tr_read<v_rd_off(D0, 2, 0)>(vb), h2 = tr_read<v_rd_off(D0, 2, 1)>(vb), l3 = tr_read<v_rd_off(D0, 3, 0)>(vb), h3 = tr_read<v_rd_off(D0, 3, 1)>(vb);
    asm volatile("s_waitcnt lgkmcnt(0)" ::: "memory"); ATT_SBAR();
#define ATT_PK(L, H) (bf16x8){L[0], L[1], L[2], L[3], H[0], H[1], H[2], H[3]}
    od = __builtin_amdgcn_mfma_f32_32x32x16_bf16(pa0, ATT_PK(l0, h0), od, 0, 0, 0);
    od = __builtin_amdgcn_mfma_f32_32x32x16_bf16(pa1, ATT_PK(l1, h1), od, 0, 0, 0);
    od = __builtin_amdgcn_mfma_f32_32x32x16_bf16(pa2, ATT_PK(l2, h2), od, 0, 0, 0);
    od = __builtin_amdgcn_mfma_f32_32x32x16_bf16(pa3, ATT_PK(l3, h3), od, 0, 0, 0);
#undef ATT_PK
}
__device__ __forceinline__ void pv_d0(f32x16* o, int vb, bf16x8 pa0, bf16x8 pa1, bf16x8 pa2, bf16x8 pa3) {
    pv_one<0>(o[0], vb, pa0, pa1, pa2, pa3); pv_one<1>(o[1], vb, pa0, pa1, pa2, pa3); pv_one<2>(o[2], vb, pa0, pa1, pa2, pa3); pv_one<3>(o[3], vb, pa0, pa1, pa2, pa3);
}
__device__ __forceinline__ void attn_unit(const unsigned char* __restrict__ Qb, const unsigned char* __restrict__ Kh, const bf16_t* __restrict__ Vh, bf16_t* __restrict__ Ob, int ldo, char* lds) {
    int tid = threadIdx.x; asm volatile("" : "+v"(tid));
    const int wid = __builtin_amdgcn_readfirstlane(tid >> 6), lane = tid & 63, r32 = lane & 31, hi = lane >> 5;
    char* K_lds = lds + L_K; char* V_lds = lds + L_V;
    float* ws = (float*)(lds + L_WS) + wid * 64; float* li_l = ws; float* al_l = ws + 32;
    float m_reg = 0.f, l_reg = 0; f32x16 o[4] = {}; v8i_a qr[3];
    const char* Qw = (const char*)Qb + (size_t)(wid * 32 + r32) * DQK + hi * 32;
#pragma unroll
    for (int s = 0; s < 3; ++s) qr[s] = ld32(Qw + s * 64, Qw + s * 64 + 16);
    const int vb0 = (int)(uintptr_t)(LAS char*)(V_lds) + v_rd_base(lane);
#define ATT_DMA_K(t, b) do { const char* _g = (const char*)Kh + (size_t)(t) * KT_BYTES; int _ln = lane; asm volatile("" : "+v"(_ln)); _Pragma("unroll") for (int _i = 0; _i < 2; ++_i) { \
        if (_i * 8 + wid < 12) { const int _p = (_i * 8 + wid) * 64 + _ln, _row = _p / 12, _cp = _p % 12, _c = (_cp & ~3) | ((_cp & 3) ^ ((_row >> 2) & 3)); \
        __builtin_amdgcn_global_load_lds((const unsigned*)(_g + (unsigned)(_row * 192 + _c * 16)), (LAS unsigned*)(K_lds + (b) * KT_BYTES + (_i * 8 + wid) * 1024), 16, 0, 0); } } } while (0)
#define ATT_DMA_V(t, b) do { const char* _g = (const char*)Vh + (size_t)(t) * VT_BYTES; int _ln = lane; asm volatile("" : "+v"(_ln)); _Pragma("unroll") for (int _i = 0; _i < 2; ++_i) { \
        const int _off = ((_i * 8 + wid) * 64 + _ln) * 16, _sub = _off >> 9, _within = _off & 511, _kk = (_sub >> 2) * 8 + (_within >> 6), _k = (_kk & ~0xC) | ((_kk & 4) << 1) | ((_kk & 8) >> 1), _c = (_sub & 3) * 32 + ((_within & 63) >> 1); \
        __builtin_amdgcn_global_load_lds((const unsigned*)(_g + (unsigned)(_k * 256 + _c * 2)), (LAS unsigned*)(V_lds + (b) * VT_BYTES + (_i * 8 + wid) * 1024), 16, 0, 0); } } while (0)
#define ATT_WB() do { asm volatile("s_waitcnt vmcnt(0)" ::: "memory"); __builtin_amdgcn_s_barrier(); asm volatile("" ::: "memory"); } while (0)
#define ATT_RESC(a) do { if (__any((a) < 1.f)) { if (hi == 0) al_l[r32] = (a); asm volatile("s_waitcnt lgkmcnt(0)" ::: "memory"); \
    _Pragma("unroll") for (int d = 0; d < 4; ++d) _Pragma("unroll") for (int r = 0; r < 16; ++r) o[d][r] *= al_l[crow(r, hi)]; } } while (0)
    f32x16 pA0, pA1, pB0, pB1; float mnA, mnB, alA, alB; bf16x8 pa0, pa1, pa2, pa3; constexpr int NT = SEQ / 64;
    ATT_DMA_K(0, 0); ATT_WB();
    ATT_DMA_K(1, 1); ATT_DMA_V(0, 0);
    qkt(pA0, pA1, K_lds, qr, r32, hi, m_reg); partialSM(pA0, pA1, m_reg, mnA, alA);
    ATT_WB();
    for (int j = 1; j + 1 < NT; j += 2) {
        ATT_DMA_K(j + 1, 0); ATT_DMA_V(j, 1);
        ATT_SBAR(); qkt(pB0, pB1, K_lds + KT_BYTES, qr, r32, hi, m_reg);
        finishSM(pA0, pA1, mnA, alA, l_reg, pa0, pa1, pa2, pa3); ATT_SBAR();
        pv_d0(o, vb0, pa0, pa1, pa2, pa3); partialSM(pB0, pB1, m_reg, mnB, alB);
        ATT_RESC(alB); ATT_WB();
        ATT_DMA_K(j + 2, 1); ATT_DMA_V(j + 1, 0);
        ATT_SBAR(); qkt(pA0, pA1, K_lds, qr, r32, hi, m_reg);
        finishSM(pB0, pB1, mnB, alB, l_reg, pa0, pa1, pa2, pa3); ATT_SBAR();
        pv_d0(o, vb0 + VT_BYTES, pa0, pa1, pa2, pa3); partialSM(pA0, pA1, m_reg, mnA, alA);
        ATT_RESC(alA); ATT_WB();
    }
    ATT_DMA_V(NT - 1, 1);
    ATT_SBAR(); qkt(pB0, pB1, K_lds + KT_BYTES, qr, r32, hi, m_reg);
    finishSM(pA0, pA1, mnA, alA, l_reg, pa0, pa1, pa2, pa3); ATT_SBAR();
    pv_d0(o, vb0, pa0, pa1, pa2, pa3); partialSM(pB0, pB1, m_reg, mnB, alB);
    ATT_RESC(alB); ATT_WB();
    finishSM(pB0, pB1, mnB, alB, l_reg, pa0, pa1, pa2, pa3); ATT_SBAR();
    pv_d0(o, vb0 + VT_BYTES, pa0, pa1, pa2, pa3);
    if (hi == 0) li_l[r32] = l_reg; asm volatile("s_waitcnt lgkmcnt(0)" ::: "memory");
    float rli[16];
#pragma unroll
    for (int r = 0; r < 16; ++r) rli[r] = __builtin_amdgcn_rcpf(li_l[crow(r, hi)]);
    __builtin_amdgcn_s_barrier(); asm volatile("" ::: "memory");
    unsigned char* st = (unsigned char*)(lds + wid * 4096);
#pragma unroll
    for (int r = 0; r < 16; ++r) { const int orow = crow(r, hi);
#pragma unroll
        for (int d0 = 0; d0 < 4; ++d0) { const float v = o[d0][r] * rli[r]; st[orow * 128 + d0 * 32 + r32] = (unsigned char)(__builtin_amdgcn_cvt_pk_fp8_f32(v, v, 0, false) & 0xff); } }
    asm volatile("s_waitcnt lgkmcnt(0)" ::: "memory");
#pragma unroll
    for (int i = 0; i < 4; ++i) { const int q = i * 64 + lane, row = q >> 3, c = q & 7;
        *(u32x4*)((unsigned char*)Ob + (size_t)(wid * 32 + row) * ldo + c * 16) = *(const u32x4*)(st + row * 128 + c * 16); }
    asm volatile("s_waitcnt lgkmcnt(0)" ::: "memory"); __builtin_amdgcn_s_barrier(); asm volatile("" ::: "memory");
#undef ATT_DMA_K
#undef ATT_DMA_V
#undef ATT_WB
#undef ATT_RESC
}
}

namespace hg {
constexpr int O_QT = 0, O_KT = 16384, O_QD = 32768, O_KTT = 49152, O_VT = 65536, O_AM = 81920, O_ST = 90112, O_PART = 122880, O_SL = 126976, O_SP = 127488;
__device__ __forceinline__ int sw256(int row, int cb) { return row * 256 + (cb ^ ((row & 15) << 4)); }
__device__ __forceinline__ int sw128(int row, int cb) { return row * 128 + (cb ^ (((row >> 1) & 7) << 4)); }
__device__ __forceinline__ bf16x8 ld8(LAS unsigned char* p) { return *(const LAS bf16x8*)p; }
__device__ __forceinline__ void hgrn_chain(LAS unsigned char* lds, unsigned char* ws, const float* lb_fwd, const float* lb_bwd, int chain) {
    const int b = chain >> 4, h = (chain >> 1) & 7, dir = chain & 1;
    const bf16_t* RQ = (const bf16_t*)(ws + WS_RQ); const bf16_t* RZ = (const bf16_t*)(ws + (dir ? WS_RFB : WS_RFF)); const bf16_t* RI = (const bf16_t*)(ws + WS_RI);
    bf16_t* O = (bf16_t*)(ws + (dir ? WS_OB : WS_OF));
    int tid = threadIdx.x; asm volatile("" : "+v"(tid));
    const int wid = __builtin_amdgcn_readfirstlane(tid >> 6), lane = tid & 63, r32 = lane & 31, hi = lane >> 5;
    const int k0 = 2 * lane;
    const float* lbp = dir ? lb_bwd : lb_fwd;
    const float lb0 = sigmoidf_(lbp[h * 128 + k0] - lbp[1024 + h * 128 + k0]), lb1 = sigmoidf_(lbp[h * 128 + k0 + 1] - lbp[1024 + h * 128 + k0 + 1]);
    LAS float* PART = (LAS float*)(lds + O_PART); LAS float* SL = (LAS float*)(lds + O_SL); LAS float* SP = (LAS float*)(lds + O_SP);
    for (int i = tid; i < 32768 / 16; i += 512) ((LAS u32x4*)(lds + O_ST))[i] = (u32x4){0u, 0u, 0u, 0u};
    f32x16 S0 = {}, S1 = {};
    unsigned zc[8], qc[8]; u32x4 va, vb;
    const size_t colbase = (size_t)h * 128;
    const int ipair = tid >> 4, c16 = tid & 15;
#define HG_TT(c, i) (dir ? (2047 - (64 * (c) + (i))) : (64 * (c) + (i)))
#define HG_LOAD(c) do { _Pragma("unroll") for (int s = 0; s < 8; ++s) { const size_t off = ((size_t)(b * 2048 + HG_TT(c, 8 * wid + s))) * 1024 + colbase + k0; zc[s] = *(const unsigned*)(RZ + off); qc[s] = *(const unsigned*)(RQ + off); } \
        va = *(const u32x4*)(RI + ((size_t)(b * 2048 + HG_TT(c, 2 * ipair))) * 1024 + colbase + c16 * 8); vb = *(const u32x4*)(RI + ((size_t)(b * 2048 + HG_TT(c, 2 * ipair + 1))) * 1024 + colbase + c16 * 8); } while (0)
    HG_LOAD(0);
    for (int c = 0; c < 32; ++c) {
        float Lp0[8], Lp1[8], kk0[8], kk1[8]; float run0 = 1.f, run1 = 1.f;
#pragma unroll
        for (int s = 0; s < 8; ++s) { const float f0 = lb0 + (1.0f - lb0) * sigmoidf_(bf_lo(zc[s])), f1 = lb1 + (1.0f - lb1) * sigmoidf_(bf_hi(zc[s]));
            run0 *= f0; run1 *= f1; Lp0[s] = run0; Lp1[s] = run1; kk0[s] = 1.0f - f0; kk1[s] = 1.0f - f1; }
        *(LAS f32x2*)(PART + wid * 128 + k0) = (f32x2){run0, run1};
        __syncthreads();
        { float pre0 = 1.f, pre1 = 1.f, p31_0 = 1.f, p31_1 = 1.f, pl0 = 1.f, pl1 = 1.f;
#pragma unroll
          for (int q = 0; q < 8; ++q) { const f32x2 t = *(const LAS f32x2*)(PART + q * 128 + k0); if (q < wid) { pre0 *= t.x; pre1 *= t.y; } if (q < 4) { p31_0 *= t.x; p31_1 *= t.y; } pl0 *= t.x; pl1 *= t.y; }
          const float r31_0 = __builtin_amdgcn_rcpf(fmaxf(p31_0, 1e-37f)), r31_1 = __builtin_amdgcn_rcpf(fmaxf(p31_1, 1e-37f));
          float kt0[8], kt1[8];
#pragma unroll
          for (int s = 0; s < 8; ++s) { const int i = 8 * wid + s; const float P0 = pre0 * Lp0[s], P1 = pre1 * Lp1[s];
              const float rP0 = __builtin_amdgcn_rcpf(fmaxf(P0, 1e-37f)), rP1 = __builtin_amdgcn_rcpf(fmaxf(P1, 1e-37f));
              const float q0 = bf_lo(qc[s]), q1 = bf_hi(qc[s]);
              const float qd0 = q0 * P0, qd1 = q1 * P1; kt0[s] = kk0[s] * (p31_0 * rP0); kt1[s] = kk1[s] * (p31_1 * rP1);
              const int ad = sw256(i, 4 * lane);
              *(LAS unsigned*)(lds + O_QT + ad) = cvt_pk_bf16(qd0 * r31_0, qd1 * r31_1); *(LAS unsigned*)(lds + O_KT + ad) = cvt_pk_bf16(kt0[s], kt1[s]); *(LAS unsigned*)(lds + O_QD + ad) = cvt_pk_bf16(qd0, qd1); }
          u32x4 w0, w1; w0.x = cvt_pk_bf16(kt0[0], kt0[1]); w0.y = cvt_pk_bf16(kt0[2], kt0[3]); w0.z = cvt_pk_bf16(kt0[4], kt0[5]); w0.w = cvt_pk_bf16(kt0[6], kt0[7]);
          w1.x = cvt_pk_bf16(kt1[0], kt1[1]); w1.y = cvt_pk_bf16(kt1[2], kt1[3]); w1.z = cvt_pk_bf16(kt1[4], kt1[5]); w1.w = cvt_pk_bf16(kt1[6], kt1[7]);
          *(LAS u32x4*)(lds + O_KTT + sw128(k0, 16 * wid)) = w0; *(LAS u32x4*)(lds + O_KTT + sw128(k0 + 1, 16 * wid)) = w1;
          if (wid == 0) { *(LAS f32x2*)(SL + k0) = (f32x2){pl0, pl1}; *(LAS f32x2*)(SP + k0) = (f32x2){pl0 * r31_0, pl1 * r31_1}; } }
        { const unsigned a4[4] = {va.x, va.y, va.z, va.w}, b4[4] = {vb.x, vb.y, vb.z, vb.w};
#pragma unroll
          for (int e = 0; e < 8; ++e) { const unsigned lo = (e & 1) ? (a4[e >> 1] >> 16) : (a4[e >> 1] & 0xffffu), hi16 = (e & 1) ? (b4[e >> 1] & 0xffff0000u) : (b4[e >> 1] << 16);
              *(LAS unsigned*)(lds + O_VT + sw128(c16 * 8 + e, 4 * ipair)) = lo | hi16; } }
        if (c + 1 < 32) HG_LOAD(c + 1);
        __syncthreads();
        if (wid < 4) { const int si = wid >> 1, ti = wid & 1; f32x16 a = {};
#pragma unroll
            for (int ks = 0; ks < 8; ++ks) { const int cb = (16 * ks + 8 * hi) * 2;
                a = __builtin_amdgcn_mfma_f32_32x32x16_bf16(ld8(lds + O_KT + sw256(32 * si + r32, cb)), ld8(lds + O_QT + sw256(32 * ti + r32, cb)), a, 0, 0, 0); }
            const int t = 32 * ti + r32;
#pragma unroll
            for (int q = 0; q < 4; ++q) { const int s0 = 32 * si + 8 * q + 4 * hi; float v[4];
#pragma unroll
                for (int j = 0; j < 4; ++j) v[j] = (s0 + j <= t) ? a[4 * q + j] : 0.f;
                u32x2 w; w.x = cvt_pk_bf16(v[0], v[1]); w.y = cvt_pk_bf16(v[2], v[3]); *(LAS u32x2*)(lds + O_AM + sw128(t, s0 * 2)) = w; } }
        const int vi = wid >> 1, ii = wid & 1; f32x16 oacc = {};
#pragma unroll
        for (int ks = 0; ks < 8; ++ks) { const int cb = (16 * ks + 8 * hi) * 2;
            oacc = __builtin_amdgcn_mfma_f32_32x32x16_bf16(ld8(lds + O_ST + sw256(32 * vi + r32, cb)), ld8(lds + O_QD + sw256(32 * ii + r32, cb)), oacc, 0, 0, 0); }
        const int ki = wid >> 1;
        float sl[16], sp[16];
#pragma unroll
        for (int r = 0; r < 16; ++r) { const int kr = 32 * ki + (r & 3) + 8 * (r >> 2) + 4 * hi; sl[r] = SL[kr]; sp[r] = SP[kr]; }
        { f32x16 P = {}; const int v2 = 2 * (wid & 1);
#pragma unroll
          for (int ks = 0; ks < 4; ++ks) { const int cb = (16 * ks + 8 * hi) * 2;
              P = __builtin_amdgcn_mfma_f32_32x32x16_bf16(ld8(lds + O_KTT + sw128(32 * ki + r32, cb)), ld8(lds + O_VT + sw128(32 * v2 + r32, cb)), P, 0, 0, 0); }
#pragma unroll
          for (int r = 0; r < 16; ++r) S0[r] = sl[r] * S0[r] + sp[r] * P[r]; }
        { f32x16 P = {}; const int v2 = 2 * (wid & 1) + 1;
#pragma unroll
          for (int ks = 0; ks < 4; ++ks) { const int cb = (16 * ks + 8 * hi) * 2;
              P = __builtin_amdgcn_mfma_f32_32x32x16_bf16(ld8(lds + O_KTT + sw128(32 * ki + r32, cb)), ld8(lds + O_VT + sw128(32 * v2 + r32, cb)), P, 0, 0, 0); }
#pragma unroll
          for (int r = 0; r < 16; ++r) S1[r] = sl[r] * S1[r] + sp[r] * P[r]; }
        __syncthreads();
#pragma unroll
        for (int ks = 0; ks < 4; ++ks) { const int cb = (16 * ks + 8 * hi) * 2;
            oacc = __builtin_amdgcn_mfma_f32_32x32x16_bf16(ld8(lds + O_VT + sw128(32 * vi + r32, cb)), ld8(lds + O_AM + sw128(32 * ii + r32, cb)), oacc, 0, 0, 0); }
        { const int i = 32 * ii + r32; const int tt = dir ? (2047 - (64 * c + i)) : (64 * c + i); bf16_t* orow = O + ((size_t)(b * 2048 + tt)) * 1024 + colbase + 32 * vi + 4 * hi;
#pragma unroll
          for (int q = 0; q < 4; ++q) { u32x2 w; w.x = cvt_pk_bf16(oacc[4 * q], oacc[4 * q + 1]); w.y = cvt_pk_bf16(oacc[4 * q + 2], oacc[4 * q + 3]); *(u32x2*)(orow + 8 * q) = w; } }
#pragma unroll
        for (int q = 0; q < 4; ++q) { const int k0 = 32 * ki + 8 * q + 4 * hi; const int v0 = 32 * (2 * (wid & 1)) + r32, v1 = v0 + 32;
            u32x2 w; w.x = cvt_pk_bf16(S0[4 * q], S0[4 * q + 1]); w.y = cvt_pk_bf16(S0[4 * q + 2], S0[4 * q + 3]); *(LAS u32x2*)(lds + O_ST + sw256(v0, k0 * 2)) = w;
            w.x = cvt_pk_bf16(S1[4 * q], S1[4 * q + 1]); w.y = cvt_pk_bf16(S1[4 * q + 2], S1[4 * q + 3]); *(LAS u32x2*)(lds + O_ST + sw256(v1, k0 * 2)) = w; }
#ifdef HG_EXTRA_BAR
        __syncthreads();
#endif
    }
    __syncthreads();
#undef HG_LOAD
#undef HG_TT
}
}
constexpr int N_PHASES = 14;

__device__ __forceinline__ void build_group_tab(Frame& F) {
    LAS int* tab = (LAS int*)(F.lds + GTAB_OFF);
    if (F.wave == 0) {
        const int c = (int)__hip_atomic_load((unsigned*)(F.ctl + CW_CNT + 64 * F.lane), RLX_AGENT);
        int ti = (c + 255) >> 8, ci = c;
#pragma unroll
        for (int o = 1; o < 64; o <<= 1) { const int a = __shfl_up(ti, o), b2 = __shfl_up(ci, o); if (F.lane >= o) { ti += a; ci += b2; } }
        tab[F.lane + 1] = ti; tab[66 + F.lane] = c; tab[132 + F.lane] = ci - c;
        if (F.lane == 63) { tab[65] = ti + T / 256; tab[66 + 64] = T; tab[132 + 64] = ci; }
        if (F.lane == 0) tab[0] = 0;
    }
    __syncthreads();
}

__global__ void __launch_bounds__(NWAVES * 64, 2) hymba_fwd(Args args) {
    extern __shared__ __attribute__((aligned(16))) unsigned char lds_raw[];
    Frame F;
    F.lds = (LAS unsigned char*)lds_raw;
    F.tid = threadIdx.x; F.lane = F.tid & 63; F.wave = __builtin_amdgcn_readfirstlane(F.tid >> 6);
    F.G = gridDim.x; F.bid = blockIdx.x;
    F.ws = args.ws; F.ctl = (gu32*)(args.ws + WS_CTL); F.out = args.out;
    for (int u = F.tid; u < (LDS_BYTES - LDSCTL_OFF) / 4; u += NWAVES * 64) ((LAS unsigned*)(F.lds + LDSCTL_OFF))[u] = 0u;
    __syncthreads();
    volatile LAS unsigned* MISC = (volatile LAS unsigned*)(F.lds + MISC_OFF);
    const int lo = args.ph_lo, hi = args.ph_hi;
    const bool fused = (hi - lo) > 1;
    XcdBarrier bar; bar.bar = (unsigned*)(F.ctl + CW_BAR); bar.x = 0; bar.st = nullptr;
    if (fused) bar = xcd_barrier_post((unsigned*)(F.ctl + CW_BAR), MISC + 8);
#ifndef PH_MASK
#define PH_MASK 0x3fff
#endif
#define IN(k) (((PH_MASK >> (k)) & 1) && lo <= (k) && (k) < hi)
#define SEAM(k) do { if (IN(k) && IN((k) + 1)) xcd_barrier(bar); { int _t = threadIdx.x; asm volatile("" : "+v"(_t)); F.tid = _t; F.lane = _t & 63; F.wave = __builtin_amdgcn_readfirstlane(_t >> 6); } } while (0)
    unsigned char* ws = args.ws;

#ifndef NCONV_BLOCKS
#define NCONV_BLOCKS 0
#endif
    if (IN(0)) { p0_prologue(F, args); if (NCONV_BLOCKS == 0) convert_experts(F, args, 0, F.G); } SEAM(0);
#if INPROJ_FP8
    if (IN(1)) { rms_mod_rows<false, false, true>(F, args, AIN(I_X), nullptr, AIN(I_N1W), 0, 2048, nullptr, ws + WS_H); } SEAM(1);
#else
    if (IN(1)) { rms_mod_rows<false, true, false>(F, args, AIN(I_X), nullptr, AIN(I_N1W), 0, 2048, (bf16_t*)(ws + WS_H), nullptr); } SEAM(1);
#endif
#if INPROJ_FP8
    if (IN(2)) { pg8::DenseOrder S; S.init(ws + WS_H, 2048, ws + WS_WIN, 2048, T, INCP, F.G, F.bid); EpiInProj E{ws, 1.0f / 32.0f}; pg8::gemm_phase<EpiInProj, pg8::DenseOrder, true, true, true>(F.lds, 2048, 2048, S, E); } SEAM(2);
#else
    if (IN(2)) { pg8::DenseOrder S; S.init(ws + WS_H, 4096, ws + WS_WIN, 4096, T, INCP, F.G, F.bid); EpiInProj E{ws, 1.0f}; pg8::gemm_phase<EpiInProj, pg8::DenseOrder, true, false>(F.lds, 4096, 4096, S, E); } SEAM(2);
#endif
    if (IN(3)) {
        { pg8::DenseOrder S; S.init(ws + WS_QLAT, 512, ws + WS_WUQ, 512, T, 1536, F.G, F.bid); EpiBf16 E{(bf16_t*)(ws + WS_QRAW), 1536, 1.0f / 16.0f}; pg8::gemm_phase<EpiBf16, pg8::DenseOrder, true, true, true>(F.lds, 512, 512, S, E); }
        { pg8::DenseOrder S; S.init(ws + WS_KVLAT, 512, ws + WS_WUKV, 512, T, 2048, F.G, F.bid); EpiBf16 E{(bf16_t*)(ws + WS_KVRAW), 2048, 1.0f}; pg8::gemm_phase<EpiBf16, pg8::DenseOrder>(F.lds, 512, 512, S, E); }
    } SEAM(3);
    if (IN(4)) { finalize_qkv(F, args); } SEAM(4);
    if (IN(5)) {
#ifndef NO_HGRN
        if (!(args.flags & 1)) for (int ch = F.bid; ch < 128; ch += F.G) { hg::hgrn_chain(F.lds, ws, AIN(I_LBF), AIN(I_LBB), ch);
            asm volatile("s_waitcnt vmcnt(0)" ::: "memory"); __syncthreads();
            if (threadIdx.x == 0) { __builtin_amdgcn_fence(__ATOMIC_RELEASE, "agent"); asm volatile("s_waitcnt vmcnt(0)" ::: "memory"); (void)__hip_atomic_fetch_add((unsigned*)(F.ctl + CW_HGDONE), 1u, RLX_AGENT); } }
#endif
#ifndef NCONV_BLOCKS
#define NCONV_BLOCKS 0
#endif
#if NCONV_BLOCKS > 0
        if (F.bid >= F.G - NCONV_BLOCKS) convert_experts(F, args, F.G - NCONV_BLOCKS, NCONV_BLOCKS);
        __syncthreads();
#endif
#ifndef NO_ATTN
        if (!(args.flags & 2)) { const unsigned x0 = xb_xcc_id() & 7u; unsigned k = 0;
          for (;;) {
            if (F.tid == 0) { unsigned u = 0xffffffffu;
                for (; k < 8u; ++k) { const unsigned y = (x0 + k) & 7u; const unsigned v = __hip_atomic_fetch_add((unsigned*)(F.ctl + CW_QUEUE + 16 * y), 1u, RLX_AGENT); if (v < 64u) { u = ((y + 8u * (v >> 3)) << 3) | (v & 7u); break; } }
                MISC[0] = u; }
            __syncthreads(); const unsigned u = MISC[0]; __syncthreads();
            if (u >= 512u) break;
            const int bh = (int)(u >> 3), qb = (int)(u & 7), b = bh >> 3, h = bh & 7;
            att::attn_unit(ws + WS_Q + ((size_t)bh * SEQ + qb * 256) * DQK, ws + WS_K + (size_t)bh * SEQ * DQK, (const bf16_t*)(ws + WS_V) + (size_t)bh * SEQ * DV,
                           (bf16_t*)(ws + WS_CAT + ((size_t)(b * SEQ + qb * 256)) * 2048 + h * 128), 2048, (char*)lds_raw);
          } }
#endif
        { int t = threadIdx.x; asm volatile("" : "+v"(t)); F.tid = t; F.lane = t & 63; F.wave = __builtin_amdgcn_readfirstlane(t >> 6); }
        if (F.tid == 0) { unsigned sp = 0; while (__hip_atomic_load((unsigned*)(F.ctl + CW_HGDONE), __ATOMIC_RELAXED, __HIP_MEMORY_SCOPE_AGENT) < 128u) { __builtin_amdgcn_s_sleep(8); if (++sp > (1u << 22)) break; }
            __builtin_amdgcn_fence(__ATOMIC_ACQUIRE, "agent"); }
        __syncthreads();
        for (;;) {
            if (F.tid == 0) MISC[0] = __hip_atomic_fetch_add((unsigned*)(F.ctl + CW_RECQ), 1u, RLX_AGENT);
            __syncthreads(); const unsigned c = MISC[0]; __syncthreads();
            if (c >= (unsigned)(T / 32)) break;
            rec_chunk32(F, args, (int)c * 32);
        }
    } SEAM(5);
    if (IN(7)) { pg8::DenseOrder S; S.init(ws + WS_CAT, 2048, ws + WS_WOUT, 2048, T, 2048, F.G, F.bid); EpiOutProj E{(bf16_t*)(ws + WS_Y1), (const float*)(ws + WS_MOD), 1.0f / 32.0f}; pg8::gemm_phase<EpiOutProj, pg8::DenseOrder, true, true, true>(F.lds, 2048, 2048, S, E); } SEAM(7);
    if (IN(8)) { rms_mod_rows<true, true, true, true>(F, args, AIN(I_X), (const bf16_t*)(ws + WS_Y1), AIN(I_N2W), 6144, 8192, (bf16_t*)(ws + WS_H), ws + WS_H8); } SEAM(8);
    if (IN(9)) { pg8::SplitKOrder S; S.A = (const char*)(ws + WS_H); S.Bt = (const char*)(ws + WS_WRT); S.lda2 = 4096; S.KS2 = 1024; S.nM = 64; S.nS = 4; S.nwg = 256; S.G = F.G; S.c = F.bid;
        EpiRouter E{(float*)(ws + WS_LOGIT)}; pg8::gemm_phase<EpiRouter, pg8::SplitKOrder>(F.lds, 1024, 4096, S, E); } SEAM(9);
    if (IN(10)) { route_topk(F, args); } SEAM(10);
    if (IN(11)) {
        build_group_tab(F); const LAS int* tab = (const LAS int*)(F.lds + GTAB_OFF);
        pg8::GroupedOrder<true, false, 2> S; S.A = (const char*)(ws + WS_H8); S.lda2 = 2048; S.Bt = (const char*)(ws + WS_WGU); S.bexp = (size_t)1024 * 2048; S.K2 = 2048;
        S.elist = (const int*)(ws + WS_ELIST); S.ewt = nullptr; S.tab = tab; S.tpl = tab[F.lane + 1]; S.total = __builtin_amdgcn_readfirstlane(tab[65]) << 2; S.G = F.G; S.c = F.bid;
        EpiGemm1 E{ws + WS_ACT}; pg8::gemm_phase<EpiGemm1, pg8::GroupedOrder<true, false, 2>, false, true, true>(F.lds, 2048, 2048, S, E);
    } SEAM(11);
    if (IN(12)) {
        build_group_tab(F); const LAS int* tab = (const LAS int*)(F.lds + GTAB_OFF);
        pg8::GroupedOrder<false, false, 3> S; S.A = (const char*)(ws + WS_ACT); S.lda2 = 512; S.Bt = (const char*)(ws + WS_WDN); S.bexp = (size_t)2048 * 512; S.K2 = 512;
        S.elist = nullptr; S.ewt = nullptr; S.tab = tab; S.tpl = tab[F.lane + 1]; S.total = __builtin_amdgcn_readfirstlane(tab[65]) << 3; S.G = F.G; S.c = F.bid;
        EpiGemm2 E{ws + WS_Y}; pg8::gemm_phase<EpiGemm2, pg8::GroupedOrder<false, false, 3>, false, true, true>(F.lds, 512, 512, S, E);
    } SEAM(12);
    if (IN(13)) { build_group_tab(F); moe_combine(F, args); }
#undef IN
#undef SEAM
}

#ifndef MK_FUSED
#define MK_FUSED 1
#endif
extern "C" void kernel_launch(void* const* d_in, const int* in_sizes, int n_in, void* d_out, int out_size, void* d_ws, size_t ws_size, hipStream_t stream) {
    static int grid = 0;
    if (grid == 0) {
        if (n_in != 26 || in_sizes[0] != T * DM || out_size != T * DM || ws_size < WS_END) { fprintf(stderr, "kernel_launch: unexpected shapes (n_in %d, in0 %d, out %d, ws %zu < %zu)\n", n_in, n_in > 0 ? in_sizes[0] : -1, out_size, ws_size, (size_t)WS_END); grid = -1; return; }
        int dev = 0, cus = 0, per_cu = 0;
        if (hipGetDevice(&dev) != hipSuccess || hipDeviceGetAttribute(&cus, hipDeviceAttributeMultiprocessorCount, dev) != hipSuccess) { grid = -1; return; }
        if (hipFuncSetAttribute((const void*)hymba_fwd, hipFuncAttributeMaxDynamicSharedMemorySize, LDS_BYTES) != hipSuccess) { fprintf(stderr, "kernel_launch: hipFuncSetAttribute failed\n"); grid = -1; return; }
        if (hipOccupancyMaxActiveBlocksPerMultiprocessor(&per_cu, (const void*)hymba_fwd, NWAVES * 64, LDS_BYTES) != hipSuccess || per_cu < 1) fprintf(stderr, "kernel_launch: occupancy query reports %d\n", per_cu);
        (void)hipGetLastError();
        grid = cus;
    }
    if (grid < 0) return;
    if (hipMemsetAsync((char*)d_ws + WS_CTL, 0, CTL_ZERO_BYTES, stream) != hipSuccess) return;
    Args a{};
    for (int i = 0; i < 26; ++i) a.in[i] = (const float*)d_in[i];
    a.out = (float*)d_out; a.ws = (unsigned char*)d_ws;
#if MK_FUSED
    a.ph_lo = 0; a.ph_hi = N_PHASES;
    hipLaunchKernelGGL(hymba_fwd, dim3(grid), dim3(NWAVES * 64), LDS_BYTES, stream, a);
#else
#ifndef PROBE_FLAGS
#define PROBE_FLAGS 0
#endif
#ifndef PROBE_REP_MASK
#define PROBE_REP_MASK 0
#endif
#ifndef PROBE_REPS
#define PROBE_REPS 1
#endif
    for (int p = 0; p < N_PHASES; ++p) { a.ph_lo = p; a.ph_hi = p + 1; hipLaunchKernelGGL(hymba_fwd, dim3(grid), dim3(NWAVES * 64), LDS_BYTES, stream, a);
        if ((PROBE_REP_MASK >> p) & 1) for (int rep = 0; rep < PROBE_REPS; ++rep) { if (p == 5) (void)hipMemsetAsync((char*)d_ws + WS_CTL + CW_QUEUE * 4, 0, 512, stream); if (p == 10) (void)hipMemsetAsync((char*)d_ws + WS_CTL + CW_CNT * 4, 0, 65 * 64 * 4, stream); a.flags = PROBE_FLAGS; hipLaunchKernelGGL(hymba_fwd, dim3(grid), dim3(NWAVES * 64), LDS_BYTES, stream, a); a.flags = 0; } }
#endif
    const hipError_t le = hipPeekAtLastError();
    if (le != hipSuccess) fprintf(stderr, "kernel_launch: launch failed: %s\n", hipGetErrorName(le));
}
```

```cpp
#include <hip/hip_runtime.h>
#include <cstdio>
#include <cstdint>

#ifndef INPROJ_FP8
#define INPROJ_FP8 1
#endif
#define GAS __attribute__((address_space(1)))
#define LAS __attribute__((address_space(3)))
typedef unsigned short bf16_t;
typedef short bf16x8 __attribute__((ext_vector_type(8)));
typedef short s16x4 __attribute__((ext_vector_type(4)));
typedef float f32x4 __attribute__((ext_vector_type(4)));
typedef float f32x2 __attribute__((ext_vector_type(2)));
typedef float f32x16 __attribute__((ext_vector_type(16)));
typedef unsigned u32x4 __attribute__((ext_vector_type(4)));
typedef unsigned u32x2 __attribute__((ext_vector_type(2)));
typedef GAS unsigned gu32;

constexpr int NB = 8, SEQ = 2048, DM = 2048, T = NB * SEQ;
constexpr int NH = 8, DQK = 192, DNOPE = 128, DROPE = 64, DV = 128;
constexpr int QLORA = 512, KVLORA = 256;
constexpr int RH = 8, RK = 128, RV = 128, RQK = 1024, RW = 1024, RCHUNK = 64;
constexpr int INC = 5952, INCP = 6144;
constexpr int NE = 64, TOPK = 8, NGRP = 8, TOPG = 4, ED = 512;
constexpr float EPS = 1e-6f, ROUTED_SCALE = 2.5f;

constexpr size_t MiB = 1u << 20;
constexpr size_t WS_CTL = 0, CTL_ZERO_BYTES = 1 * MiB;
constexpr size_t KiB = 1024;
constexpr size_t WS_MOD = 1 * MiB;
constexpr size_t WS_ELIST = 2 * MiB;
constexpr size_t WS_SLOTEP = 6 * MiB + 512 * KiB;
constexpr size_t WS_SLOTW = 7 * MiB + 512 * KiB;
constexpr size_t WS_WIN = 11 * MiB;
constexpr size_t WS_WUQ = 35 * MiB;
constexpr size_t WS_WUKV = 36 * MiB + 512 * KiB;
constexpr size_t WS_WRT = 37 * MiB + 512 * KiB;
constexpr size_t WS_WOUT = 38 * MiB + 512 * KiB;
constexpr size_t WS_WDN = 46 * MiB + 512 * KiB;
constexpr size_t WS_H = WS_WDN + 130 * MiB;
constexpr size_t WS_WGU = WS_H + 64 * MiB;
constexpr size_t WS_MIX = WS_WGU + 260 * MiB;
constexpr size_t WS_QLAT = WS_MIX;
constexpr size_t WS_KVLAT = WS_QLAT + 16 * MiB;
constexpr size_t WS_KROPE = WS_KVLAT + 8 * MiB;
constexpr size_t WS_RQ = WS_KROPE + 2 * MiB;
constexpr size_t WS_RFF = WS_RQ + 32 * MiB, WS_RFB = WS_RFF + 32 * MiB, WS_RI = WS_RFB + 32 * MiB, WS_RG = WS_RI + 32 * MiB;
constexpr size_t WS_QRAW = WS_RG + 32 * MiB;
constexpr size_t WS_KVRAW = WS_QRAW + 48 * MiB;
constexpr size_t WS_Q = WS_KVRAW + 64 * MiB;
constexpr size_t WS_K = WS_Q + 48 * MiB;
constexpr size_t WS_V = WS_K + 48 * MiB;
constexpr size_t WS_CAT = WS_V + 32 * MiB;
constexpr size_t WS_Y1 = WS_RFF;
constexpr size_t WS_H8 = WS_QRAW;
constexpr size_t WS_OF = WS_QRAW, WS_OB = WS_QRAW + 32 * MiB;
constexpr size_t WS_Y = WS_WGU;
constexpr size_t WS_ACT = WS_Y + 576 * MiB;
constexpr size_t WS_LOGIT = WS_ACT + 145 * MiB;
constexpr size_t WS_END = 1024 * MiB;
static_assert(WS_CAT + 64 * MiB <= WS_END && WS_LOGIT + 16 * MiB <= WS_END && WS_SLOTW + 512 * KiB <= WS_WIN && WS_ELIST + 65 * 64 * KiB <= WS_SLOTEP, "ws map");

constexpr int CW_TMO = 0, CW_CODE = 1;
constexpr int CW_BAR = 4096;
constexpr int CW_CNT = 16384;
constexpr int CW_QUEUE = 32768;
constexpr int CW_HGDONE = 32768 + 1024;
constexpr int CW_RECQ = 32768 + 1088;
constexpr int CW_CVQ = 32768 + 1152;

constexpr int RING_BYTES = 131072;
constexpr int LDSCTL_OFF = RING_BYTES, MISC_OFF = LDSCTL_OFF + 320;
constexpr int LDS_BYTES = 147456;
constexpr int NWAVES = 8;

#define RLX_AGENT __ATOMIC_RELAXED, __HIP_MEMORY_SCOPE_AGENT
#define LDS_WAIT() asm volatile("s_waitcnt lgkmcnt(0)" ::: "memory")
#define VM_WAIT() asm volatile("s_waitcnt vmcnt(0)" ::: "memory")
__device__ __forceinline__ unsigned cvt_pk_bf16(float lo, float hi) { unsigned r; asm volatile("v_cvt_pk_bf16_f32 %0, %1, %2" : "=v"(r) : "v"(lo), "v"(hi)); return r; }
__device__ __forceinline__ float bf_lo(unsigned w) { return __uint_as_float(w << 16); }
__device__ __forceinline__ float bf_hi(unsigned w) { return __uint_as_float(w & 0xffff0000u); }
__device__ __forceinline__ float bf2f(bf16_t b) { return __uint_as_float(((unsigned)b) << 16); }
__device__ __forceinline__ bf16_t f2bf(float f) { return (bf16_t)(cvt_pk_bf16(f, 0.f) & 0xffffu); }
__device__ __forceinline__ float wave_sum(float v) {
#pragma unroll
    for (int o = 1; o < 64; o <<= 1) v += __shfl_xor(v, o);
    return v;
}
__device__ __forceinline__ float sigmoidf_(float x) { return __builtin_amdgcn_rcpf(1.0f + __expf(-x)); }
__device__ __forceinline__ float siluf_(float x) { return x * __builtin_amdgcn_rcpf(1.0f + __expf(-x)); }
#define XB_TMO      128
#define XB_XCNT(j)  (256  + 64 * (j))
#define XB_XSUB(j)  (1280 + 64 * (j))
#define XB_XGEN(j)  (2304 + 64 * (j))
#define XB_TOP      3328
#define XB_TOPGEN   3392
#define XCD_BAR_WORDS 3456
#define XB_SPIN_CAP (1u << 18)

__device__ __forceinline__ unsigned xb_ld(unsigned* p)              { return __hip_atomic_load(p, __ATOMIC_RELAXED, __HIP_MEMORY_SCOPE_AGENT); }
__device__ __forceinline__ unsigned xb_add(unsigned* p, unsigned v) { return __hip_atomic_fetch_add(p, v, __ATOMIC_RELAXED, __HIP_MEMORY_SCOPE_AGENT); }
__device__ __forceinline__ unsigned xb_xcc_id() { return (unsigned)__builtin_amdgcn_s_getreg((3 << 11) | 20) & 0xFu; }
#define XB_SPIN(cond, bar) do { unsigned _sp = 0; while (cond) { __builtin_amdgcn_s_sleep(1); \
    if ((++_sp & 255u) == 0u) { if (xb_ld(&(bar)[XB_TMO])) break; if (_sp > XB_SPIN_CAP) { atomicAdd(&(bar)[XB_TMO], 1u); break; } } } } while (0)

struct XcdBarrier {
    unsigned* bar; unsigned x;
    volatile LAS unsigned* st;
};

__device__ __forceinline__ XcdBarrier xcd_barrier_post(unsigned* bar, volatile LAS unsigned* st) {
    XcdBarrier b; b.bar = bar; b.x = xb_xcc_id(); b.st = st;
    if (threadIdx.x == 0) (void)xb_add(&bar[XB_XCNT(b.x)], 1u);
    return b;
}
__device__ __forceinline__ void xcd_barrier_complete(unsigned* bar, unsigned x, unsigned& nloc, unsigned& nx) {
    const unsigned G = gridDim.x * gridDim.y * gridDim.z;
    unsigned sum, cnt, mine, sp = 0u;
    for (;;) {
        sum = 0u; cnt = 0u; mine = 0u;
#pragma unroll
        for (unsigned j = 0; j < 16; ++j) { const unsigned c = xb_ld(&bar[XB_XCNT(j)]); sum += c; cnt += (c > 0u) ? 1u : 0u; mine = (j == x) ? c : mine; }
        if (sum == G) break;
        __builtin_amdgcn_s_sleep(1);
        if ((++sp & 255u) == 0u) { if (xb_ld(&bar[XB_TMO])) break; if (sp > XB_SPIN_CAP) { atomicAdd(&bar[XB_TMO], 1u); break; } }
    }
    nloc = mine > 0u ? mine : 1u; nx = cnt > 0u ? cnt : 1u;
}

__device__ __forceinline__ void xcd_barrier(const XcdBarrier& b) {
    asm volatile("s_waitcnt vmcnt(0)" ::: "memory");
    __syncthreads();
    if (threadIdx.x == 0) {
        unsigned* bar = b.bar;
        __builtin_amdgcn_s_waitcnt(0);
        unsigned nloc = b.st[0], nx = b.st[1];
        if (nloc == 0u) { xcd_barrier_complete(bar, b.x, nloc, nx); b.st[0] = nloc; b.st[1] = nx; }
        const unsigned old = xb_add(&bar[XB_XSUB(b.x)], 1u);
        const unsigned gen = old / nloc;
        if (old + 1u == (gen + 1u) * nloc) {
            __builtin_amdgcn_fence(__ATOMIC_RELEASE, "agent");
            asm volatile("s_waitcnt vmcnt(0)" ::: "memory");
            const unsigned og = xb_add(&bar[XB_TOP], 1u);
            const unsigned tg = og / nx;
            if (og + 1u == (tg + 1u) * nx) xb_add(&bar[XB_TOPGEN], 1u);
            else XB_SPIN(xb_ld(&bar[XB_TOPGEN]) == tg, bar);
            __builtin_amdgcn_fence(__ATOMIC_ACQUIRE, "agent");
            xb_add(&bar[XB_XGEN(b.x)], 1u);
            asm volatile("s_waitcnt vmcnt(0)" ::: "memory");
        } else {
            XB_SPIN(xb_ld(&bar[XB_XGEN(b.x)]) == gen, bar);
            __builtin_amdgcn_fence(__ATOMIC_ACQUIRE, "agent");
            asm volatile("s_waitcnt vmcnt(0)" ::: "memory");
        }
    }
    __syncthreads();
}
namespace pg8 {
constexpr int BM = 256, BK = 64, HALF = 128, HTB = HALF * BK * 2, STAGE_BYTES = 8 * HTB, NXCD = 8, WGM = 8;
__host__ __device__ __forceinline__ int lds_byte(int r, int c) { const int st = (r >> 4) * 2 + (c >> 5), rr = r & 15, cc = c & 31, ob = rr * 64 + cc * 2; return st * 1024 + (ob ^ (((ob >> 9) & 1) << 5)); }
__host__ __device__ __forceinline__ void stage_rc(int b, int& R, int& C) { const int st = b / 1024, sb = b % 1024, swz = sb ^ (((sb >> 9) & 1) << 5); R = (st >> 1) * 16 + swz / 64; C = (st & 1) * 32 + (swz % 64) / 2; }
__host__ __device__ __forceinline__ int gray2(int x) { return x ^ (x >> 1); }
__host__ __device__ __forceinline__ int lds_byte8(int r, int cbyte) { const int st = (r >> 4) * 2 + (cbyte >> 6), rr = r & 15, ch = (cbyte & 63) >> 4; return st * 1024 + rr * 64 + ((ch ^ gray2(rr >> 2)) << 4) + (cbyte & 15); }
__host__ __device__ __forceinline__ void stage_rc8(int b, int& R, int& Cbyte) { const int st = b / 1024, sb = b % 1024, rr = sb / 64, slot = (sb % 64) >> 4; R = (st >> 1) * 16 + rr; Cbyte = (st & 1) * 64 + ((slot ^ gray2(rr >> 2)) << 4) + (sb & 15); }
__host__ __device__ __forceinline__ int perm32(int rho) { const int n = rho >> 4, i = rho & 15; return 8 * (i >> 2) + 4 * n + (i & 3); }

struct Unit { int pm, pn, e, mt, rows, row0; };

struct DenseOrder {
    static constexpr bool GATHER = false;
    const char* A; const char* Bt; int lda2  , K2  ; int nM, nN, nwg, G, c;
    __device__ void init(const void* A_, int ldaBytes, const void* Bt_, int ldbBytes, int M, int N, int G_, int c_) { A = (const char*)A_; Bt = (const char*)Bt_; lda2 = ldaBytes; K2 = ldbBytes; nM = M / BM; nN = N / BM; nwg = nM * nN; G = G_; c = c_; }
    __device__ __forceinline__ bool next(int i, Unit& u) const {
        const long L = (long)i * G + c; if (L >= nwg) return false;
        int wgid = (int)L; { const int q = nwg / NXCD, r = nwg % NXCD, xcd = wgid % NXCD, off = wgid / NXCD; wgid = (xcd < r ? xcd * (q + 1) : r * (q + 1) + (xcd - r) * q) + off; }
        const int nig = WGM * nN, gid = wgid / nig, fm = gid * WGM, gsz = (nM - fm) < WGM ? (nM - fm) : WGM;
        u.pm = fm + ((wgid % nig) % gsz); u.pn = (wgid % nig) / gsz; u.e = 0; u.mt = 0; u.rows = 256; u.row0 = u.pm * 256; return true;
    }
    __device__ __forceinline__ void meta_prefetch(const Unit&, int, LAS unsigned char*, int) const {}
    __device__ __forceinline__ void a_addr(const Unit& u, int, LAS unsigned char*, int R0, int Cb, const char*& base, unsigned (&ao)[4]) const {
        base = A + (size_t)u.pm * 256 * lda2;
#pragma unroll
        for (int j = 0; j < 4; ++j) ao[j] = (unsigned)((R0 + 64 * j) * lda2 + Cb);
    }
    __device__ __forceinline__ const char* b_addr(const Unit& u) const { return Bt + (size_t)u.pn * 256 * K2; }
    __device__ __forceinline__ size_t arow64() const { return (size_t)64 * lda2; }
};

struct SplitKOrder {
    static constexpr bool GATHER = false;
    const char* A; const char* Bt; int lda2, KS2  ; int nM, nS, nwg, G, c;
    __device__ __forceinline__ bool next(int i, Unit& u) const {
        const long L = (long)i * G + c; if (L >= nwg) return false;
        u.pm = (int)L / nS; u.pn = (int)L % nS; u.e = 0; u.mt = 0; u.rows = 256; u.row0 = u.pm * 256; return true;
    }
    __device__ __forceinline__ void meta_prefetch(const Unit&, int, LAS unsigned char*, int) const {}
    __device__ __forceinline__ void a_addr(const Unit& u, int, LAS unsigned char*, int R0, int Cb, const char*& base, unsigned (&ao)[4]) const {
        base = A + (size_t)u.pm * 256 * lda2 + (size_t)u.pn * KS2;
#pragma unroll
        for (int j = 0; j < 4; ++j) ao[j] = (unsigned)((R0 + 64 * j) * lda2 + Cb);
    }
    __device__ __forceinline__ const char* b_addr(const Unit& u) const { return Bt + (size_t)u.pn * KS2; }
    __device__ __forceinline__ size_t arow64() const { return (size_t)64 * lda2; }
};

typedef int v8i_t __attribute__((ext_vector_type(8)));
__device__ __forceinline__ int pg8_xor16(int a) { int r; asm volatile("v_xor_b32 %0, 16, %1" : "=v"(r) : "v"(a)); return r; }
struct Frag2 { u32x4 lo, hi; };
template <bool F8> struct FragSel { typedef Frag2 T; };
template <> struct FragSel<true> { typedef v8i_t T; };
template <class Epi, class Sched, bool ALIGN_EPI = true, bool FP8 = false, bool SWZ8 = false>
__device__ __forceinline__ void gemm_phase(LAS unsigned char* lds, const int Kb, const int ldbB, const Sched& S, const Epi& E) {
    int tid = threadIdx.x; asm volatile("" : "+v"(tid));
    const int wid = __builtin_amdgcn_readfirstlane(tid >> 6), lane = tid & 63, wr = wid >> 2, wc = wid & 3, fr = lane & 15, fq = lane >> 4;
    const int nt = Kb / 128;
    int R0, C0; if constexpr (FP8 && SWZ8) { int cb; stage_rc8(tid * 16, R0, cb); C0 = cb >> 1; } else stage_rc(tid * 16, R0, C0);
    unsigned voffB[2];
    { const int Rb = Epi::PERM ? (64 * (R0 >> 5) + 16 * ((R0 & 15) >> 2) + 4 * ((R0 >> 4) & 1) + (R0 & 3)) : R0; voffB[0] = (unsigned)(Rb * ldbB + C0 * 2); voffB[1] = voffB[0]; }
    const size_t pstepB = (size_t)(Epi::PERM ? 128 : 64) * ldbB;
    const size_t kstep = (size_t)(BK * 2);
    const size_t hstepB = (size_t)(Epi::PERM ? 8 : HALF) * ldbB;
    const unsigned ldsw = (unsigned)wid * 1024u;
    const int aoffL = (FP8 && SWZ8) ? lds_byte8(wr * 64 + fr, fq * 32) : (FP8 ? lds_byte(wr * 64 + fr, fq * 16) : lds_byte(wr * 64 + fr, fq * 8)), aoffH1k = FP8 ? aoffL + 16 : aoffL + 1024;
    int boffL = ((FP8 && SWZ8) ? lds_byte8(wc * 32 + fr, fq * 32) : (FP8 ? lds_byte(wc * 32 + fr, fq * 16) : lds_byte(wc * 32 + fr, fq * 8))) + 65536; asm volatile("" : "+v"(boffL)); const int boffH1k = FP8 ? boffL + 16 : boffL + 1024;
#define PG8_SA(b, h) (((b) * 2 + (h)) * HTB)
#define PG8_SB(b, h) ((4 + (b) * 2 + (h)) * HTB)
    const unsigned ldsb = (unsigned)__builtin_amdgcn_readfirstlane((int)(unsigned)(uintptr_t)lds) + ldsw;
#define PG8_DMA(gb, vo, ldst) asm volatile("s_mov_b32 m0, %2\n\ts_nop 0\n\tglobal_load_lds_dwordx4 %0, %1" :: "v"(vo), "s"(gb), "s"(ldst) : "memory")
#define PG8_STAGE(bufoff, gbase, voff) do { const char* _gb = (const char*)(gbase); _Pragma("unroll") for (int _i = 0; _i < 2; ++_i) PG8_DMA(_gb + (size_t)_i * pstepB, (voff)[0], ldsb + (unsigned)((bufoff) + _i * 8192)); } while (0)
#define PG8_STAGE_A(bufoff, gbase, aov, h) do { const char* _gb = (const char*)(gbase); _Pragma("unroll") for (int _i = 0; _i < 2; ++_i) { \
        if constexpr (Sched::GATHER) PG8_DMA(_gb, (aov)[(h) * 2 + _i], ldsb + (unsigned)((bufoff) + _i * 8192)); \
        else PG8_DMA(_gb + (size_t)((h) * 2 + _i) * S.arow64(), (aov)[0], ldsb + (unsigned)((bufoff) + _i * 8192)); } } while (0)
#define PG8_LDF(dst, off0, off1) do { const u32x4 _lo = *(const LAS u32x4*)(lds + (off0)), _hi = *(const LAS u32x4*)(lds + (off1)); \
        if constexpr (FP8) dst = (v8i_t){(int)_lo.x, (int)_lo.y, (int)_lo.z, (int)_lo.w, (int)_hi.x, (int)_hi.y, (int)_hi.z, (int)_hi.w}; else { dst.lo = _lo; dst.hi = _hi; } } while (0)
#define PG8_HI(lo, hi1k) ((FP8 && SWZ8) ? pg8_xor16(lo) : (hi1k))
#define PG8_LDA(dst, b, h) do { const int _hio = PG8_HI(aoffL, aoffH1k); _Pragma("unroll") for (int m = 0; m < 4; ++m) PG8_LDF(dst[m], PG8_SA(b, h) + aoffL + m * 2048, PG8_SA(b, h) + _hio + m * 2048); } while (0)
#define PG8_LDB(dst, b, h) do { const int _hio = PG8_HI(boffL, boffH1k); _Pragma("unroll") for (int n = 0; n < 2; ++n) PG8_LDF(dst[n], (PG8_SB(b, h) - 65536) + boffL + n * 2048, (PG8_SB(b, h) - 65536) + _hio + n * 2048); } while (0)
#define PG8_MMA(ai, bj, At, Bt) do { __builtin_amdgcn_s_setprio(1); _Pragma("unroll") for (int m = 0; m < 4; ++m) _Pragma("unroll") for (int n = 0; n < 2; ++n) { \
        if constexpr (FP8) acc[ai][bj][m][n] = __builtin_amdgcn_mfma_scale_f32_16x16x128_f8f6f4(Bt[n], At[m], acc[ai][bj][m][n], 0, 0, 0, 0, 0, 0);     \
        else { acc[ai][bj][m][n] = __builtin_amdgcn_mfma_f32_16x16x32_bf16(__builtin_bit_cast(bf16x8, Bt[n].lo), __builtin_bit_cast(bf16x8, At[m].lo), acc[ai][bj][m][n], 0, 0, 0); \
            acc[ai][bj][m][n] = __builtin_amdgcn_mfma_f32_16x16x32_bf16(__builtin_bit_cast(bf16x8, Bt[n].hi), __builtin_bit_cast(bf16x8, At[m].hi), acc[ai][bj][m][n], 0, 0, 0); } } \
        __builtin_amdgcn_s_setprio(0); } while (0)
#define PG8_LDA2(dst, b, h) do { const int _hio = PG8_HI(aoffL, aoffH1k); _Pragma("unroll") for (int m = 0; m < 2; ++m) PG8_LDF(dst[m], PG8_SA(b, h) + aoffL + m * 2048, PG8_SA(b, h) + _hio + m * 2048); } while (0)
#define PG8_MF(ai, bj, m, Av, Bt) do { _Pragma("unroll") for (int n = 0; n < 2; ++n) acc[ai][bj][m][n] = __builtin_amdgcn_mfma_scale_f32_16x16x128_f8f6f4(Bt[n], Av, acc[ai][bj][m][n], 0, 0, 0, 0, 0, 0); } while (0)
#define PG8_MMA8(ai, At, B0, B1, b, h) do { __builtin_amdgcn_s_setprio(1); const int _hio = PG8_HI(aoffL, aoffH1k); \
        PG8_MF(ai, 0, 0, At[0], B0); PG8_MF(ai, 1, 0, At[0], B1); PG8_LDF(At[0], PG8_SA(b, h) + aoffL + 2 * 2048, PG8_SA(b, h) + _hio + 2 * 2048); \
        PG8_MF(ai, 0, 1, At[1], B0); PG8_MF(ai, 1, 1, At[1], B1); PG8_LDF(At[1], PG8_SA(b, h) + aoffL + 3 * 2048, PG8_SA(b, h) + _hio + 3 * 2048); \
        PG8_MF(ai, 0, 2, At[0], B0); PG8_MF(ai, 1, 2, At[0], B1); PG8_MF(ai, 0, 3, At[1], B0); PG8_MF(ai, 1, 3, At[1], B1); __builtin_amdgcn_s_setprio(0); } while (0)
#define PG8_WAIT_V(n) asm volatile("s_waitcnt vmcnt(" #n ")" ::: "memory")
#define PG8_WAIT_L(n) asm volatile("s_waitcnt lgkmcnt(" #n ")" ::: "memory")
#define PG8_BAR __builtin_amdgcn_s_barrier()
#define PG8_SCHED __builtin_amdgcn_sched_barrier(0)
    Unit cur, nxt; int ui = 0;
    if (!S.next(0, cur)) return;
    f32x4 acc[2][2][4][2];
#pragma unroll
    for (int a = 0; a < 2; ++a)
#pragma unroll
        for (int b = 0; b < 2; ++b)
#pragma unroll
            for (int m = 0; m < 4; ++m)
#pragma unroll
                for (int n = 0; n < 2; ++n) acc[a][b][m][n] = (f32x4){0.f, 0.f, 0.f, 0.f};
    typename FragSel<FP8>::T At[4], B0[2], B1[2];
    const char* cA; unsigned cao[4]; const char* nA; unsigned nao[4];
    int mslot = 0;
    if constexpr (Sched::GATHER) { S.meta_prefetch(cur, 0, lds, wid); PG8_WAIT_V(0); __syncthreads(); }
    S.a_addr(cur, 0, lds, R0, C0 * 2, cA, cao);
    const char* cB = S.b_addr(cur);
    PG8_STAGE(PG8_SB(0, 0), cB, voffB); PG8_STAGE(PG8_SB(0, 1), cB + hstepB, voffB); PG8_STAGE_A(PG8_SA(0, 0), cA, cao, 0); PG8_STAGE_A(PG8_SA(0, 1), cA, cao, 1);
    if (wr == 1) PG8_BAR;
    PG8_WAIT_V(2); PG8_BAR;
    PG8_STAGE(PG8_SB(1, 0), cB + kstep, voffB); PG8_STAGE_A(PG8_SA(1, 0), cA + kstep, cao, 0); PG8_STAGE(PG8_SB(1, 1), cB + hstepB + kstep, voffB);
    PG8_WAIT_V(6); PG8_BAR;
    for (;;) {
        const bool has_next = S.next(ui + 1, nxt);
        const int nslot = (mslot == 2) ? 0 : mslot + 1;
        if constexpr (Sched::GATHER) { if (has_next) S.meta_prefetch(nxt, nslot, lds, wid); }
        const char* nB = has_next ? S.b_addr(nxt) : cB;
#pragma unroll 1
        for (int t = 0; t < nt; t += 2) {
            const bool last = (t == nt - 2);
            const char* a1 = cA + (size_t)(t + 1) * kstep;
            const char* b2 = last ? nB : cB + (size_t)(t + 2) * kstep;
            const char* b3 = b2 + kstep;
            if constexpr (FP8) {
            PG8_LDB(B0, 0, 0); PG8_LDB(B1, 0, 1); PG8_SCHED; PG8_LDA2(At, 0, 0); PG8_STAGE_A(PG8_SA(1, 1), a1, cao, 1);
            PG8_WAIT_V(8); PG8_WAIT_L(0); PG8_BAR; PG8_MMA8(0, At, B0, B1, 0, 0); PG8_BAR; PG8_SCHED;
            if (last) {
                if (has_next) { S.a_addr(nxt, nslot, lds, R0, C0 * 2, nA, nao); cA = nA;
#pragma unroll
                    for (int j = 0; j < 4; ++j) cao[j] = nao[j]; }
            }
            const char* a2 = last ? cA : cA + (size_t)(t + 2) * kstep;
            const char* a3 = a2 + kstep;
            PG8_LDA2(At, 0, 1); PG8_STAGE(PG8_SB(0, 0), b2, voffB); PG8_STAGE(PG8_SB(0, 1), b2 + hstepB, voffB); PG8_STAGE_A(PG8_SA(0, 0), a2, cao, 0);
            PG8_WAIT_V(8); PG8_WAIT_L(0); PG8_BAR; PG8_MMA8(1, At, B0, B1, 0, 1); PG8_BAR; PG8_SCHED;
            PG8_LDB(B0, 1, 0); PG8_LDB(B1, 1, 1); PG8_SCHED; PG8_LDA2(At, 1, 0); PG8_STAGE_A(PG8_SA(0, 1), a2, cao, 1);
            PG8_WAIT_V(8); PG8_WAIT_L(0); PG8_BAR; PG8_MMA8(0, At, B0, B1, 1, 0); PG8_BAR; PG8_SCHED;
            PG8_LDA2(At, 1, 1); PG8_STAGE(PG8_SB(1, 0), b3, voffB); PG8_STAGE(PG8_SB(1, 1), b3 + hstepB, voffB); PG8_STAGE_A(PG8_SA(1, 0), a3, cao, 0);
            PG8_WAIT_V(8); PG8_WAIT_L(0); PG8_BAR; PG8_MMA8(1, At, B0, B1, 1, 1); PG8_BAR; PG8_SCHED;
            } else {
            PG8_LDB(B0, 0, 0); PG8_LDB(B1, 0, 1); PG8_SCHED; PG8_LDA(At, 0, 0); PG8_STAGE_A(PG8_SA(1, 1), a1, cao, 1);
            PG8_WAIT_V(8); PG8_WAIT_L(0); PG8_BAR; PG8_MMA(0, 0, At, B0); PG8_MMA(0, 1, At, B1); PG8_BAR; PG8_SCHED;
            if (last) {
                if (has_next) { S.a_addr(nxt, nslot, lds, R0, C0 * 2, nA, nao); cA = nA;
#pragma unroll
                    for (int j = 0; j < 4; ++j) cao[j] = nao[j]; }
            }
            const char* a2 = last ? cA : cA + (size_t)(t + 2) * kstep;
            const char* a3 = a2 + kstep;
            PG8_LDA(At, 0, 1); PG8_STAGE(PG8_SB(0, 0), b2, voffB); PG8_STAGE(PG8_SB(0, 1), b2 + hstepB, voffB); PG8_STAGE_A(PG8_SA(0, 0), a2, cao, 0);
            PG8_WAIT_V(8); PG8_WAIT_L(0); PG8_BAR; PG8_MMA(1, 0, At, B0); PG8_MMA(1, 1, At, B1); PG8_BAR; PG8_SCHED;
            PG8_LDB(B0, 1, 0); PG8_LDB(B1, 1, 1); PG8_SCHED; PG8_LDA(At, 1, 0); PG8_STAGE_A(PG8_SA(0, 1), a2, cao, 1);
            PG8_WAIT_V(8); PG8_WAIT_L(0); PG8_BAR; PG8_MMA(0, 0, At, B0); PG8_MMA(0, 1, At, B1); PG8_BAR; PG8_SCHED;
            PG8_LDA(At, 1, 1); PG8_STAGE(PG8_SB(1, 0), b3, voffB); PG8_STAGE(PG8_SB(1, 1), b3 + hstepB, voffB); PG8_STAGE_A(PG8_SA(1, 0), a3, cao, 0);
            PG8_WAIT_V(8); PG8_WAIT_L(0); PG8_BAR; PG8_MMA(1, 0, At, B0); PG8_MMA(1, 1, At, B1); PG8_BAR; PG8_SCHED;
            }
        }
        if constexpr (ALIGN_EPI) { if (wr == 0) PG8_BAR; }
        E(acc, cur, mslot, lds, wr, wc, fr, fq);
        if (!has_next) break;
#pragma unroll
        for (int a = 0; a < 2; ++a)
#pragma unroll
            for (int b = 0; b < 2; ++b)
#pragma unroll
                for (int m = 0; m < 4; ++m)
#pragma unroll
                    for (int n = 0; n < 2; ++n) acc[a][b][m][n] = (f32x4){0.f, 0.f, 0.f, 0.f};
        cur = nxt; cB = nB; ++ui; mslot = nslot;
        if constexpr (ALIGN_EPI) { if (wr == 1) PG8_BAR; }
    }
    PG8_WAIT_V(0);
    if constexpr (!ALIGN_EPI) { if (wr == 0) PG8_BAR; }
    PG8_BAR;
#undef PG8_SA
#undef PG8_SB
#undef PG8_STAGE
#undef PG8_STAGE_A
#undef PG8_DMA
#undef PG8_LDA
#undef PG8_LDA2
#undef PG8_MF
#undef PG8_MMA8
#undef PG8_HI
#undef PG8_LDF
#undef PG8_LDB
#undef PG8_MMA
#undef PG8_WAIT_V
#undef PG8_WAIT_L
#undef PG8_BAR
#undef PG8_SCHED
}
}
constexpr int GTAB_OFF = LDSCTL_OFF + 1024;
constexpr int META_OFF = LDSCTL_OFF + 4096;
namespace pg8 {
template <bool GATHER_A, bool NEED_W, int NTSHIFT>
struct GroupedOrder {
    static constexpr bool GATHER = GATHER_A;
    const char* A; int lda2; const char* Bt; size_t bexp; int K2; const int* elist; const float* ewt; const LAS int* tab; int tpl; int total; int G, c;
    __device__ __forceinline__ bool next(int i, Unit& u) const {
        int mtg;
        if (G == 256) { constexpr int NT = 1 << NTSHIFT, RPX = 32 / NT;
            mtg = i * (256 / NT) + RPX * (c & 7) + (c >> (3 + NTSHIFT)); u.pn = (c >> 3) & (NT - 1); if (mtg >= (total >> NTSHIFT)) return false; }
        else { const long L = (long)i * G + c; if (L >= total) return false; mtg = (int)L >> NTSHIFT; u.pn = (int)L & ((1 << NTSHIFT) - 1); }
        const int e = __popcll(__ballot(tpl <= mtg));
        const int tpe = __builtin_amdgcn_readfirstlane(tab[e]), cn = __builtin_amdgcn_readfirstlane(tab[66 + e]), ro = __builtin_amdgcn_readfirstlane(tab[132 + e]);
        u.e = e; u.pm = 0; u.mt = mtg - tpe; const int rem = cn - u.mt * 256; u.rows = rem < 256 ? rem : 256; u.row0 = ro + u.mt * 256; return true;
    }
    __device__ __forceinline__ void meta_prefetch(const Unit& u, int slot, LAS unsigned char* lds, int wid) const {
        if (wid == 0) {
            const int lane = threadIdx.x & 63;
            __builtin_amdgcn_global_load_lds((const unsigned*)(elist + (size_t)u.e * 16384 + u.mt * 256 + lane * 4), (LAS unsigned*)(lds + META_OFF + slot * 2048), 16, 0, 0);
            if (NEED_W) __builtin_amdgcn_global_load_lds((const unsigned*)(ewt + (size_t)u.e * 16384 + u.mt * 256 + lane * 4), (LAS unsigned*)(lds + META_OFF + slot * 2048 + 1024), 16, 0, 0);
        }
    }
    __device__ __forceinline__ void a_addr(const Unit& u, int slot, LAS unsigned char* lds, int R0, int Cb, const char*& base, unsigned (&ao)[4]) const {
        if constexpr (GATHER_A) {
            base = A; const LAS int* me = (const LAS int*)(lds + META_OFF + slot * 2048);
#pragma unroll
            for (int j = 0; j < 4; ++j) { const int r = R0 + 64 * j; const int en = me[r]; const int tok = (r < u.rows) ? (en >> 3) : 0; ao[j] = (unsigned)tok * (unsigned)lda2 + (unsigned)Cb; }
        } else {
            base = A + (size_t)u.row0 * lda2;
#pragma unroll
            for (int j = 0; j < 4; ++j) ao[j] = (unsigned)((R0 + 64 * j) * lda2 + Cb);
        }
    }
    __device__ __forceinline__ const char* b_addr(const Unit& u) const { return Bt + (size_t)u.e * bexp + (size_t)u.pn * 256 * K2; }
    __device__ __forceinline__ size_t arow64() const { return (size_t)64 * lda2; }
};
}

typedef f32x4 Acc[2][2][4][2];
__device__ __forceinline__ unsigned pk4_fp8(float a, float b, float c, float d);

struct EpiInProj {
    static constexpr bool PERM = true;
    unsigned char* ws; float oscale;
    __device__ __forceinline__ void operator()(const Acc& acc, const pg8::Unit& u, int, LAS unsigned char*, int wr, int wc, int fr, int fq) const {
        asm volatile("" : "+v"(fr), "+v"(fq));
        bf16_t* base; int ld, c0, ncv = 256;
        const int pn = u.pn;
        const int row0 = u.pm * 256 + wr * 64 + fr, colw = wc * 64 + 16 * fq;
        if (pn < 2) {
            unsigned char* q8 = ws + WS_QLAT;
#pragma unroll
            for (int ai = 0; ai < 2; ++ai)
#pragma unroll
                for (int m = 0; m < 4; ++m) { const f32x4 a0 = acc[ai][0][m][0] * oscale, a1 = acc[ai][0][m][1] * oscale, b0 = acc[ai][1][m][0] * oscale, b1 = acc[ai][1][m][1] * oscale;
                    u32x4 w; w.x = pk4_fp8(a0[0], a0[1], a0[2], a0[3]); w.y = pk4_fp8(a1[0], a1[1], a1[2], a1[3]); w.z = pk4_fp8(b0[0], b0[1], b0[2], b0[3]); w.w = pk4_fp8(b1[0], b1[1], b1[2], b1[3]);
                    *(u32x4*)(q8 + (size_t)(row0 + ai * 128 + m * 16) * 512 + pn * 256 + colw) = w; }
            return; }
        if (pn == 2) { base = (bf16_t*)(ws + WS_KVLAT); ld = 256; c0 = 0; }
        else if (pn == 3) { base = (bf16_t*)(ws + WS_KROPE); ld = 64; c0 = 0; ncv = 64; }
        else { const int s = (pn - 4) >> 2; base = (bf16_t*)(ws + WS_RQ + (size_t)s * 32 * MiB); ld = 1024; c0 = ((pn - 4) & 3) * 256; }
#pragma unroll
        for (int ai = 0; ai < 2; ++ai)
#pragma unroll
            for (int m = 0; m < 4; ++m) { bf16_t* rowp = base + (size_t)(row0 + ai * 128 + m * 16) * ld + c0 + colw;
#pragma unroll
                for (int bj = 0; bj < 2; ++bj) { const f32x4 v0 = acc[ai][bj][m][0] * oscale, v1 = acc[ai][bj][m][1] * oscale;
                    u32x4 w; w.x = cvt_pk_bf16(v0[0], v0[1]); w.y = cvt_pk_bf16(v0[2], v0[3]); w.z = cvt_pk_bf16(v1[0], v1[1]); w.w = cvt_pk_bf16(v1[2], v1[3]);
                    if (colw < ncv) *(u32x4*)(rowp + bj * 8) = w; } }
    }
};
struct EpiBf16 {
    static constexpr bool PERM = true;
    bf16_t* O; int ldc; float oscale;
    __device__ __forceinline__ void operator()(const Acc& acc, const pg8::Unit& u, int, LAS unsigned char*, int wr, int wc, int fr, int fq) const {
        asm volatile("" : "+v"(fr), "+v"(fq));
        const int row0 = u.pm * 256 + wr * 64 + fr, col0 = u.pn * 256 + wc * 64 + 16 * fq;
#pragma unroll
        for (int ai = 0; ai < 2; ++ai)
#pragma unroll
            for (int m = 0; m < 4; ++m) { bf16_t* rowp = O + (size_t)(row0 + ai * 128 + m * 16) * ldc + col0;
#pragma unroll
                for (int bj = 0; bj < 2; ++bj) { const f32x4 v0 = acc[ai][bj][m][0] * oscale, v1 = acc[ai][bj][m][1] * oscale;
                    u32x4 w; w.x = cvt_pk_bf16(v0[0], v0[1]); w.y = cvt_pk_bf16(v0[2], v0[3]); w.z = cvt_pk_bf16(v1[0], v1[1]); w.w = cvt_pk_bf16(v1[2], v1[3]);
                    *(u32x4*)(rowp + bj * 8) = w; } }
    }
};
struct EpiOutProj {
    static constexpr bool PERM = true;
    bf16_t* y1; const float* mod; float oscale;
    __device__ __forceinline__ void operator()(const Acc& acc, const pg8::Unit& u, int, LAS unsigned char*, int wr, int wc, int fr, int fq) const {
        asm volatile("" : "+v"(fr), "+v"(fq));
        const int row0 = u.pm * 256 + wr * 64 + fr, col0 = u.pn * 256 + wc * 64 + 16 * fq; const int b = u.pm >> 3;
        f32x4 gv[2][2];
#pragma unroll
        for (int bj = 0; bj < 2; ++bj)
#pragma unroll
            for (int n = 0; n < 2; ++n) gv[bj][n] = *(const f32x4*)(mod + (size_t)b * 12288 + 4096 + col0 + bj * 8 + n * 4) * oscale;
#pragma unroll
        for (int ai = 0; ai < 2; ++ai)
#pragma unroll
            for (int m = 0; m < 4; ++m) { bf16_t* rowp = y1 + (size_t)(row0 + ai * 128 + m * 16) * DM + col0;
#pragma unroll
                for (int bj = 0; bj < 2; ++bj) { const f32x4 v0 = acc[ai][bj][m][0] * gv[bj][0], v1 = acc[ai][bj][m][1] * gv[bj][1];
                    u32x4 w; w.x = cvt_pk_bf16(v0[0], v0[1]); w.y = cvt_pk_bf16(v0[2], v0[3]); w.z = cvt_pk_bf16(v1[0], v1[1]); w.w = cvt_pk_bf16(v1[2], v1[3]);
                    *(u32x4*)(rowp + bj * 8) = w; } }
    }
};
struct EpiRouter {
    static constexpr bool PERM = false;
    float* logit;
    __device__ __forceinline__ void operator()(const Acc& acc, const pg8::Unit& u, int, LAS unsigned char*, int wr, int wc, int fr, int fq) const {
        asm volatile("" : "+v"(fr), "+v"(fq));
        if (wc >= 2) return;
        const int row0 = u.pm * 256 + wr * 64 + fr, col0 = wc * 32 + 4 * fq;
#pragma unroll
        for (int ai = 0; ai < 2; ++ai)
#pragma unroll
            for (int m = 0; m < 4; ++m) { float* rowp = logit + (size_t)u.pn * T * 64 + (size_t)(row0 + ai * 128 + m * 16) * 64 + col0;
#pragma unroll
                for (int n = 0; n < 2; ++n) *(f32x4*)(rowp + n * 16) = acc[ai][0][m][n]; }
    }
};
struct EpiGemm1 {
    static constexpr bool PERM = true;
    unsigned char* act;
    __device__ __forceinline__ void operator()(const Acc& acc, const pg8::Unit& u, int, LAS unsigned char*, int wr, int wc, int fr, int fq) const {
        asm volatile("" : "+v"(fr), "+v"(fq));
        const int r0 = wr * 64 + fr, col0 = u.pn * 128 + wc * 32 + 8 * fq;
#pragma unroll
        for (int ai = 0; ai < 2; ++ai)
#pragma unroll
            for (int m = 0; m < 4; ++m) { const int r = r0 + ai * 128 + m * 16;
                float o[8];
#pragma unroll
                for (int n = 0; n < 2; ++n)
#pragma unroll
                    for (int j = 0; j < 4; ++j) { const float g = acc[ai][0][m][n][j] * (1.0f / 32.0f), up = acc[ai][1][m][n][j] * (1.0f / 32.0f); o[n * 4 + j] = g * __builtin_amdgcn_rcpf(1.0f + __expf(-g)) * up; }
                u32x2 w; w.x = pk4_fp8(o[0], o[1], o[2], o[3]); w.y = pk4_fp8(o[4], o[5], o[6], o[7]);
                if (r < u.rows) *(u32x2*)(act + (size_t)(u.row0 + r) * ED + col0) = w; }
    }
};
struct EpiGemm2 {
    static constexpr bool PERM = true;
    unsigned char* Y;
    __device__ __forceinline__ void operator()(const Acc& acc, const pg8::Unit& u, int, LAS unsigned char*, int wr, int wc, int fr, int fq) const {
        asm volatile("" : "+v"(fr), "+v"(fq));
        const int r0 = wr * 64 + fr, col0 = u.pn * 256 + wc * 64 + 16 * fq; const float s = 1.0f / 16.0f;
#pragma unroll
        for (int ai = 0; ai < 2; ++ai)
#pragma unroll
            for (int m = 0; m < 4; ++m) { const int r = r0 + ai * 128 + m * 16;
                const f32x4 a0 = acc[ai][0][m][0] * s, a1 = acc[ai][0][m][1] * s, b0 = acc[ai][1][m][0] * s, b1 = acc[ai][1][m][1] * s;
                u32x4 w; w.x = pk4_fp8(a0[0], a0[1], a0[2], a0[3]); w.y = pk4_fp8(a1[0], a1[1], a1[2], a1[3]); w.z = pk4_fp8(b0[0], b0[1], b0[2], b0[3]); w.w = pk4_fp8(b1[0], b1[1], b1[2], b1[3]);
                if (r < u.rows) *(u32x4*)(Y + (size_t)(u.row0 + r) * DM + col0) = w; }
    }
};
struct Args { const float* in[26]; float* out; unsigned char* ws; int ph_lo, ph_hi, flags, pad; };
struct Frame {
    LAS unsigned char* lds;
    gu32* ctl;
    int tid, lane, wave, G, bid;
    float* out; unsigned char* ws;
};
#define KARG_PTR(off) (*(const float* const volatile __attribute__((address_space(4)))*)((const __attribute__((address_space(4))) char*)__builtin_amdgcn_kernarg_segment_ptr() + (off)))
#define AIN(i) KARG_PTR(8 * (i))
enum { I_X = 0, I_C, I_POS, I_WADA, I_BADA, I_N1W, I_WIN, I_QLNW, I_WUQ, I_KVLNW, I_WUKV, I_QNW, I_KNW, I_LBF, I_LBB, I_RNW, I_WOUT, I_N2W, I_WRT, I_RBIAS, I_WEG, I_WEU, I_WED, I_WSG, I_WSU, I_WSD };

template <bool F8 = false> __device__ __forceinline__ void conv_item64(const float* W, int N, bf16_t* WT, int ldk, int dst_row0, const float* kscale, int k0, int n0, int lane, float wscale = 1.0f) {
    const int n4 = (lane & 15) * 4, kg = lane >> 4;
    f32x4 v[2][8];
#pragma unroll
    for (int r = 0; r < 2; ++r)
#pragma unroll
        for (int i = 0; i < 8; ++i) v[r][i] = *(const f32x4*)(W + (size_t)(k0 + 32 * r + 8 * kg + i) * N + n0 + n4);
#pragma unroll
    for (int r = 0; r < 2; ++r) { const int kb = k0 + 32 * r + 8 * kg;
        if (kscale) {
#pragma unroll
            for (int i = 0; i < 8; ++i) v[r][i] = v[r][i] * kscale[kb + i]; }
#pragma unroll
        for (int j = 0; j < 4; ++j) {
            if constexpr (F8) { u32x2 o; o.x = pk4_fp8(v[r][0][j] * wscale, v[r][1][j] * wscale, v[r][2][j] * wscale, v[r][3][j] * wscale); o.y = pk4_fp8(v[r][4][j] * wscale, v[r][5][j] * wscale, v[r][6][j] * wscale, v[r][7][j] * wscale);
                *(u32x2*)((unsigned char*)WT + (size_t)(dst_row0 + n4 + j) * ldk + kb) = o; }
            else { u32x4 o; o.x = cvt_pk_bf16(v[r][0][j], v[r][1][j]); o.y = cvt_pk_bf16(v[r][2][j], v[r][3][j]); o.z = cvt_pk_bf16(v[r][4][j], v[r][5][j]); o.w = cvt_pk_bf16(v[r][6][j], v[r][7][j]);
                *(u32x4*)(WT + (size_t)(dst_row0 + n4 + j) * ldk + kb) = o; } } }
}
__device__ __forceinline__ void p0_prologue(Frame& F, const Args& args) {
    if (F.bid < 192) {
        LAS float* cond = (LAS float*)F.lds;
        LAS float* red = (LAS float*)(F.lds + 65536);
        for (int i = F.tid; i < 8 * 2048; i += 512) { const int b = i >> 11, k = i & 2047; const float c = AIN(I_C)[i]; cond[k * 8 + b] = siluf_(c); }
        __syncthreads();
        const int col = F.bid * 64 + F.lane; const float* wp = AIN(I_WADA) + col;
        float acc[8];
#pragma unroll
        for (int b = 0; b < 8; ++b) acc[b] = 0.f;
        const int kb = F.wave * 256;
#pragma unroll 16
        for (int k = 0; k < 256; ++k) { const float wv = wp[(size_t)(kb + k) * 12288]; const f32x4 c0 = *(const LAS f32x4*)(cond + (kb + k) * 8), c1 = *(const LAS f32x4*)(cond + (kb + k) * 8 + 4);
            acc[0] += c0[0] * wv; acc[1] += c0[1] * wv; acc[2] += c0[2] * wv; acc[3] += c0[3] * wv; acc[4] += c1[0] * wv; acc[5] += c1[1] * wv; acc[6] += c1[2] * wv; acc[7] += c1[3] * wv; }
#pragma unroll
        for (int b = 0; b < 8; ++b) red[(F.wave * 8 + b) * 64 + F.lane] = acc[b];
        __syncthreads();
        { const int b = F.wave; float s = AIN(I_BADA)[col];
#pragma unroll
          for (int w = 0; w < 8; ++w) s += red[(w * 8 + b) * 64 + F.lane];
          ((float*)(F.ws + WS_MOD))[b * 12288 + col] = s; }
        __syncthreads();
    }
    { u32x4 z = {0u, 0u, 0u, 0u}; u32x4* p0 = (u32x4*)(F.ws + WS_WIN + (size_t)832 * (INPROJ_FP8 ? 2048 : 4096)); u32x4* p1 = (u32x4*)(F.ws + WS_WRT + (size_t)64 * 4096);
      for (int i = F.bid * 512 + F.tid; i < 49152; i += F.G * 512) { if (i < (INPROJ_FP8 ? 24576 : 49152)) p0[i] = z; p1[i] = z; } }
}
__device__ __forceinline__ unsigned pk4_fp8(float a, float b, float c, float d) { int w = 0; w = __builtin_amdgcn_cvt_pk_fp8_f32(a, b, w, false); w = __builtin_amdgcn_cvt_pk_fp8_f32(c, d, w, true); return (unsigned)w; }
struct CvI { const float* src; unsigned char* dst; const float* kscale; int N, ldk; float scale; int gu, n0l, bf; };
constexpr int CV_NEXP = 3 * 64 * 256 + 3 * 256;
constexpr int CV_IN = 16 * 186, CV_UQ = 4 * 48, CV_UKV = 2 * 64, CV_OUT = 16 * 64, CV_RT = 16 * 2, CV_NSMALL = CV_IN + CV_UQ + CV_UKV + CV_OUT + CV_RT;
__device__ __forceinline__ void cv_decode(int r, CvI& c, unsigned char* ws) {
    unsigned char* WGU8 = ws + WS_WGU; unsigned char* WDN8 = ws + WS_WDN;
    constexpr int I_EX = 64 * 256, I_SH = 256;
    c.kscale = nullptr; c.bf = 0; c.gu = 0; c.n0l = 0;
    if (r >= CV_NEXP) {
        r -= CV_NEXP;
        if (r < CV_IN) { const int kb = r / 186, n0 = (r % 186) * 32, row = n0 + (n0 >= 832 ? 192 : 0); c.src = AIN(I_WIN) + (size_t)(kb * 128) * INC + n0; c.N = INC;
#if INPROJ_FP8
            c.dst = ws + WS_WIN + (size_t)row * 2048 + kb * 128; c.ldk = 2048; c.scale = 32.0f;
#else
            c.dst = ws + WS_WIN + (size_t)row * 4096 + kb * 256; c.ldk = 4096; c.scale = 1.0f; c.bf = 1;
#endif
            return; } r -= CV_IN;
        if (r < CV_UQ) { const int kb = r / 48, n0 = (r % 48) * 32; c.src = AIN(I_WUQ) + (size_t)(kb * 128) * 1536 + n0; c.N = 1536; c.dst = ws + WS_WUQ + (size_t)n0 * 512 + kb * 128; c.ldk = 512; c.scale = 16.0f; c.kscale = AIN(I_QLNW) + kb * 128; return; } r -= CV_UQ;
        if (r < CV_UKV) { const int kb = r / 64, n0 = (r % 64) * 32; c.src = AIN(I_WUKV) + (size_t)(kb * 128) * 2048 + n0; c.N = 2048; c.dst = ws + WS_WUKV + (size_t)n0 * 512 + kb * 256; c.ldk = 512; c.scale = 1.0f; c.bf = 1; c.kscale = AIN(I_KVLNW) + kb * 128; return; } r -= CV_UKV;
        if (r < CV_OUT) { const int kb = r / 64, n0 = (r % 64) * 32; c.src = AIN(I_WOUT) + (size_t)(kb * 128) * 2048 + n0; c.N = 2048; c.dst = ws + WS_WOUT + (size_t)n0 * 2048 + kb * 128; c.ldk = 2048; c.scale = 32.0f; return; } r -= CV_OUT;
        { const int kb = r >> 1, n0 = (r & 1) * 32; c.src = AIN(I_WRT) + (size_t)(kb * 128) * 64 + n0; c.N = 64; c.dst = ws + WS_WRT + (size_t)n0 * 4096 + kb * 256; c.ldk = 4096; c.scale = 1.0f; c.bf = 1; return; }
    }
    int sel, e, q;
    if (r < 3 * I_EX) { sel = r / I_EX; const int rr = r - sel * I_EX; e = rr >> 8; q = rr & 255; } else { const int rr = r - 3 * I_EX; sel = rr / I_SH; q = rr - sel * I_SH; e = 64; }
    if (sel < 2) { const int kb = q >> 4, n0 = (q & 15) * 32; const float* W = (e < 64) ? ((sel == 0 ? AIN(I_WEG) : AIN(I_WEU)) + (size_t)e * 2048 * 512) : (sel == 0 ? AIN(I_WSG) : AIN(I_WSU));
        c.src = W + (size_t)(kb * 128) * 512 + n0; c.N = 512; c.ldk = 2048; c.scale = 32.0f;
        c.dst = WGU8 + (size_t)e * 1024 * 2048 + (size_t)((n0 >> 7) * 256 + sel * 8) * 2048 + kb * 128; c.gu = 1; c.n0l = n0 & 127; }
    else { const int kb = q >> 6, n0 = (q & 63) * 32; const float* W = (e < 64) ? (AIN(I_WED) + (size_t)e * 512 * 2048) : AIN(I_WSD);
        c.src = W + (size_t)(kb * 128) * 2048 + n0; c.N = 2048; c.ldk = 512; c.scale = 16.0f;
        c.dst = WDN8 + (size_t)e * 2048 * 512 + (size_t)n0 * 512 + kb * 128; }
}
__device__ __forceinline__ void cv_load(const CvI& c, int lane, f32x4 (&v)[16]) {
    const float* p = c.src + (size_t)(16 * (lane >> 3)) * c.N + (lane & 7) * 4;
#pragma unroll
    for (int i = 0; i < 16; ++i) v[i] = *(const f32x4*)(p + (size_t)i * c.N);
}
__device__ __forceinline__ void cv_store(const CvI& c, int lane, f32x4 (&v)[16]) {
    const int n4 = (lane & 7) * 4, al = c.n0l + n4, kg = lane >> 3;
    const size_t row = (size_t)(c.gu ? (2 * (al & ~7) + (al & 7)) : n4); const float s = c.scale;
    if (c.kscale) {
#pragma unroll
        for (int i = 0; i < 16; ++i) v[i] = v[i] * c.kscale[16 * kg + i]; }
    if (c.bf) { unsigned char* p = c.dst + row * c.ldk + 32 * kg;
#pragma unroll
        for (int j = 0; j < 4; ++j) { u32x4 o0, o1;
            o0.x = cvt_pk_bf16(v[0][j], v[1][j]); o0.y = cvt_pk_bf16(v[2][j], v[3][j]); o0.z = cvt_pk_bf16(v[4][j], v[5][j]); o0.w = cvt_pk_bf16(v[6][j], v[7][j]);
            o1.x = cvt_pk_bf16(v[8][j], v[9][j]); o1.y = cvt_pk_bf16(v[10][j], v[11][j]); o1.z = cvt_pk_bf16(v[12][j], v[13][j]); o1.w = cvt_pk_bf16(v[14][j], v[15][j]);
            *(u32x4*)(p + (size_t)j * c.ldk) = o0; *(u32x4*)(p + (size_t)j * c.ldk + 16) = o1; }
        return; }
    unsigned char* p = c.dst + row * c.ldk + 16 * kg;
#pragma unroll
    for (int j = 0; j < 4; ++j) { u32x4 o;
        o.x = pk4_fp8(v[0][j] * s, v[1][j] * s, v[2][j] * s, v[3][j] * s); o.y = pk4_fp8(v[4][j] * s, v[5][j] * s, v[6][j] * s, v[7][j] * s);
        o.z = pk4_fp8(v[8][j] * s, v[9][j] * s, v[10][j] * s, v[11][j] * s); o.w = pk4_fp8(v[12][j] * s, v[13][j] * s, v[14][j] * s, v[15][j] * s);
        *(u32x4*)(p + (size_t)j * c.ldk) = o; }
}
__device__ __forceinline__ void convert_range(Frame& F, const Args& args, int w, int nw, int lo, int hi) {
    CvI A, B; f32x4 va[16], vb[16];
    int it = lo + w; if (it >= hi) return;
    cv_decode(it, A, F.ws); cv_load(A, F.lane, va);
    for (;;) {
        const int itn = it + nw; const bool hasn = itn < hi;
        if (hasn) { cv_decode(itn, B, F.ws); cv_load(B, F.lane, vb); }
        cv_store(A, F.lane, va);
        if (!hasn) break;
        it = itn + nw; const bool has2 = it < hi;
        if (has2) { cv_decode(it, A, F.ws); cv_load(A, F.lane, va); }
        cv_store(B, F.lane, vb);
        if (!has2) break;
    }
}
__device__ __forceinline__ void convert_experts(Frame& F, const Args& args, int b0, int nblk) {
    convert_range(F, args, (F.bid - b0) * NWAVES + F.wave, nblk * NWAVES, 0, CV_NEXP + CV_NSMALL);
}

template <bool ADD, bool OUT16, bool OUT8, bool SUM16 = false> __device__ __forceinline__ void rms_mod_rows(Frame& F, const Args& args, const float* src, const bf16_t* add, const float* nw, int sh_off, int sc_off, bf16_t* dst, unsigned char* dst8) {
    const int gw = F.bid * NWAVES + F.wave, NGW = F.G * NWAVES;
    const float* mod = (const float*)(F.ws + WS_MOD);
    for (int g0 = gw * 8; g0 < T; g0 += NGW * 8) {
        const int b = g0 >> 11;
        f32x4 a[8], sh[8];
#pragma unroll
        for (int j = 0; j < 8; ++j) { const int c = j * 256 + F.lane * 4; const f32x4 w = *(const f32x4*)(nw + c), s = *(const f32x4*)(mod + b * 12288 + sc_off + c); a[j] = w * (s + 1.0f); sh[j] = *(const f32x4*)(mod + b * 12288 + sh_off + c); }
        f32x4 nx[8]; u32x2 na[8];
        { const f32x4* xr = (const f32x4*)(src + (size_t)g0 * DM) + F.lane; const u32x2* ar = (const u32x2*)(add + (size_t)g0 * DM) + F.lane;
#pragma unroll
          for (int j = 0; j < 8; ++j) { nx[j] = xr[64 * j]; if (ADD) na[j] = ar[64 * j]; } }
        for (int m = g0; m < g0 + 8; ++m) {
            f32x4 v[8]; float s = 0.f;
#pragma unroll
            for (int j = 0; j < 8; ++j) { v[j] = nx[j]; if (ADD) { v[j].x += bf_lo(na[j].x); v[j].y += bf_hi(na[j].x); v[j].z += bf_lo(na[j].y); v[j].w += bf_hi(na[j].y); } }
            if (m + 1 < g0 + 8) { const f32x4* xr = (const f32x4*)(src + (size_t)(m + 1) * DM) + F.lane; const u32x2* ar = (const u32x2*)(add + (size_t)(m + 1) * DM) + F.lane;
#pragma unroll
                for (int j = 0; j < 8; ++j) { nx[j] = xr[64 * j]; if (ADD) na[j] = ar[64 * j]; } }
#pragma unroll
            for (int j = 0; j < 8; ++j) s += (v[j].x * v[j].x + v[j].y * v[j].y) + (v[j].z * v[j].z + v[j].w * v[j].w);
            if (SUM16) { u32x2* sr = (u32x2*)(const_cast<bf16_t*>(add) + (size_t)m * DM) + F.lane;
#pragma unroll
                for (int j = 0; j < 8; ++j) { u32x2 w; w.x = cvt_pk_bf16(v[j].x, v[j].y); w.y = cvt_pk_bf16(v[j].z, v[j].w); sr[64 * j] = w; } }
            const float rstd = __builtin_amdgcn_rsqf(wave_sum(s) * (1.f / DM) + EPS);
            u32x2* o8 = (u32x2*)(dst + (size_t)m * DM) + F.lane; unsigned* o4 = (unsigned*)(dst8 + (size_t)m * DM) + F.lane;
#pragma unroll
            for (int j = 0; j < 8; ++j) { const f32x4 y = v[j] * rstd * a[j] + sh[j];
                if (OUT16) { u32x2 w; w.x = cvt_pk_bf16(y.x, y.y); w.y = cvt_pk_bf16(y.z, y.w); o8[64 * j] = w; }
                if (OUT8) o4[64 * j] = pk4_fp8(y.x, y.y, y.z, y.w); }
        }
    }
}

__device__ __forceinline__ void add_fp8x8(const u32x2 w, float (&acc)[8]) {
    f32x2 p;
    p = __builtin_amdgcn_cvt_pk_f32_fp8((int)w.x, false); acc[0] += p.x; acc[1] += p.y; p = __builtin_amdgcn_cvt_pk_f32_fp8((int)w.x, true); acc[2] += p.x; acc[3] += p.y;
    p = __builtin_amdgcn_cvt_pk_f32_fp8((int)w.y, false); acc[4] += p.x; acc[5] += p.y; p = __builtin_amdgcn_cvt_pk_f32_fp8((int)w.y, true); acc[6] += p.x; acc[7] += p.y;
}
__device__ __forceinline__ void unpack8(const u32x4 w, float (&f)[8]) { f[0] = bf_lo(w.x); f[1] = bf_hi(w.x); f[2] = bf_lo(w.y); f[3] = bf_hi(w.y); f[4] = bf_lo(w.z); f[5] = bf_hi(w.z); f[6] = bf_lo(w.w); f[7] = bf_hi(w.w); }
__device__ __forceinline__ u32x4 pack8(const float* f) { u32x4 w; w.x = cvt_pk_bf16(f[0], f[1]); w.y = cvt_pk_bf16(f[2], f[3]); w.z = cvt_pk_bf16(f[4], f[5]); w.w = cvt_pk_bf16(f[6], f[7]); return w; }
__device__ __forceinline__ void ld8f(const LAS float* p, float (&f)[8]) { const f32x4 a = *(const LAS f32x4*)p, b = *(const LAS f32x4*)(p + 4); f[0] = a[0]; f[1] = a[1]; f[2] = a[2]; f[3] = a[3]; f[4] = b[0]; f[5] = b[1]; f[6] = b[2]; f[7] = b[3]; }
__device__ __forceinline__ u32x2 pack8_fp8(const float* f) { u32x2 w; w.x = pk4_fp8(f[0], f[1], f[2], f[3]); w.y = pk4_fp8(f[4], f[5], f[6], f[7]); return w; }
__device__ __forceinline__ void head_norm_rope_store(const LAS float* scr, const LAS float* cs, const LAS float* sn, const LAS float* nw, float oscale, unsigned char* dst, int lane) {
    const int head = lane >> 3, part = lane & 7; const LAS float* hv = scr + head * 192;
    float x0[8], x1[8], x2[8], xp[8];
    ld8f(hv + 8 * part, x0); ld8f(hv + 64 + 8 * part, x1); ld8f(hv + 128 + 8 * part, x2);
    const bool first = part < 4; const int pofs = first ? (160 + 8 * part) : (96 + 8 * part);
    ld8f(hv + pofs, xp);
    float ss = 0.f;
#pragma unroll
    for (int e = 0; e < 8; ++e) ss += x0[e] * x0[e] + x1[e] * x1[e] + x2[e] * x2[e];
    ss += __shfl_xor(ss, 1); ss += __shfl_xor(ss, 2); ss += __shfl_xor(ss, 4);
    const float r = __builtin_amdgcn_rsqf(ss * (1.f / 192.f) + EPS) * oscale;
    float w[8], o[8];
    ld8f(nw + 8 * part, w);
#pragma unroll
    for (int e = 0; e < 8; ++e) o[e] = x0[e] * w[e] * r;
    *(u32x2*)(dst + 8 * part) = pack8_fp8(o);
    ld8f(nw + 64 + 8 * part, w);
#pragma unroll
    for (int e = 0; e < 8; ++e) o[e] = x1[e] * w[e] * r;
    *(u32x2*)(dst + 64 + 8 * part) = pack8_fp8(o);
    float wp[8], c[8], sv[8];
    ld8f(nw + 128 + 8 * part, w); ld8f(nw + pofs, wp); ld8f(cs + 8 * (part & 3), c); ld8f(sn + 8 * (part & 3), sv);
#pragma unroll
    for (int e = 0; e < 8; ++e) { const float own = x2[e] * w[e], oth = xp[e] * wp[e];
        o[e] = (first ? (own * c[e] - oth * sv[e]) : (oth * sv[e] + own * c[e])) * r; }
    *(u32x2*)(dst + 128 + 8 * part) = pack8_fp8(o);
}
__device__ __forceinline__ void finalize_qkv(Frame& F, const Args& args) {
    LAS float* scr = (LAS float*)(F.lds + F.wave * 12288); LAS float* cs = scr + 2048; LAS float* sn = cs + 32;
    LAS float* qnw = (LAS float*)(F.lds + 8 * 12288); LAS float* knw = qnw + 192;
    if (F.tid < 192) qnw[F.tid] = AIN(I_QNW)[F.tid]; else if (F.tid < 384) knw[F.tid - 192] = AIN(I_KNW)[F.tid - 192];
    __syncthreads();
    const int gw = F.bid * NWAVES + F.wave, NGW = F.G * NWAVES, lane = F.lane;
    const bf16_t* QLAT = (const bf16_t*)(F.ws + WS_QLAT); const bf16_t* KVLAT = (const bf16_t*)(F.ws + WS_KVLAT); const bf16_t* KROPE = (const bf16_t*)(F.ws + WS_KROPE);
    const bf16_t* QRAW = (const bf16_t*)(F.ws + WS_QRAW); const bf16_t* KVRAW = (const bf16_t*)(F.ws + WS_KVRAW);
    unsigned char* Q = F.ws + WS_Q; unsigned char* K = F.ws + WS_K; bf16_t* V = (bf16_t*)(F.ws + WS_V);
    const float qscale = 0.07216878364870322f * 1.4426950408889634f;
    const float inv = __builtin_amdgcn_exp2f(-(float)(2 * (lane & 31)) * (13.287712379549449f / 64.f));
    u32x4 n_kvl, n_qr[3], n_kvr[4], n_kr; u32x2 n_ql8; int n_pos;
#define FQ_LOAD(tok) do { n_ql8 = *(const u32x2*)((const unsigned char*)QLAT + (size_t)(tok) * 512 + lane * 8); n_kvl = *(const u32x4*)(KVLAT + (size_t)(tok) * 256 + (lane & 31) * 8); n_kr = *(const u32x4*)(KROPE + (size_t)(tok) * 64 + (lane & 7) * 8); \
        n_pos = ((const int*)AIN(I_POS))[tok]; _Pragma("unroll") for (int j = 0; j < 3; ++j) n_qr[j] = *(const u32x4*)(QRAW + (size_t)(tok) * 1536 + (j * 64 + lane) * 8); \
        _Pragma("unroll") for (int j = 0; j < 4; ++j) n_kvr[j] = *(const u32x4*)(KVRAW + (size_t)(tok) * 2048 + (j * 64 + lane) * 8); } while (0)
    if (gw < T) FQ_LOAD(gw);
    for (int tok = gw; tok < T; tok += NGW) {
        const u32x4 c_kvl = n_kvl, c_kr = n_kr; const u32x2 c_ql8 = n_ql8; const int pos = n_pos; u32x4 c_qr[3], c_kvr[4];
#pragma unroll
        for (int j = 0; j < 3; ++j) c_qr[j] = n_qr[j];
#pragma unroll
        for (int j = 0; j < 4; ++j) c_kvr[j] = n_kvr[j];
        if (tok + NGW < T) FQ_LOAD(tok + NGW);
        const int b = tok >> 11, s = tok & 2047;
        if (lane < 32) { const float ang = (float)pos * inv;
            const float kq = rintf(ang * 0.15915494309189535f); float rr = fmaf(-kq, 6.2831854820251465f, ang); rr = fmaf(-kq, -1.7484555e-7f, rr);
            const float rev = rr * 0.15915494309189535f;
            cs[lane] = __builtin_amdgcn_cosf(rev); sn[lane] = __builtin_amdgcn_sinf(rev); }
        float f[8];
#pragma unroll
        for (int e = 0; e < 8; ++e) f[e] = 0.f;
        add_fp8x8(c_ql8, f); float sq = 0.f;
#pragma unroll
        for (int e = 0; e < 8; ++e) sq += f[e] * f[e];
        const float rstd_q = __builtin_amdgcn_rsqf(wave_sum(sq) * (1.f / 512.f) + EPS);
        float sk = 0.f;
        if (lane < 32) { unpack8(c_kvl, f);
#pragma unroll
            for (int e = 0; e < 8; ++e) sk += f[e] * f[e]; }
        const float rstd_kv = __builtin_amdgcn_rsqf(wave_sum(sk) * (1.f / 256.f) + EPS);
#pragma unroll
        for (int j = 0; j < 3; ++j) { const int ci = j * 64 + lane; unpack8(c_qr[j], f);
            *(LAS f32x4*)(scr + ci * 8) = (f32x4){f[0], f[1], f[2], f[3]} * rstd_q; *(LAS f32x4*)(scr + ci * 8 + 4) = (f32x4){f[4], f[5], f[6], f[7]} * rstd_q; }
        LDS_WAIT(); asm volatile("" ::: "memory");
        head_norm_rope_store(scr, cs, sn, qnw, qscale, Q + ((size_t)(b * NH + (lane >> 3)) * SEQ + s) * DQK, lane);
        LDS_WAIT(); asm volatile("" ::: "memory");
#pragma unroll
        for (int j = 0; j < 4; ++j) { const int ci = j * 64 + lane; const int head = ci >> 5, within = (ci & 31) * 8; unpack8(c_kvr[j], f);
#pragma unroll
            for (int e = 0; e < 8; ++e) f[e] *= rstd_kv;
            if (within < 128) { *(LAS f32x4*)(scr + head * 192 + within) = (f32x4){f[0], f[1], f[2], f[3]}; *(LAS f32x4*)(scr + head * 192 + within + 4) = (f32x4){f[4], f[5], f[6], f[7]}; }
            else *(u32x4*)(V + ((size_t)(b * NH + head) * SEQ + s) * DV + (within - 128)) = pack8(f); }
        if (lane < 8) { unpack8(c_kr, f);
#pragma unroll
            for (int h = 0; h < 8; ++h) { *(LAS f32x4*)(scr + h * 192 + 128 + lane * 8) = (f32x4){f[0], f[1], f[2], f[3]}; *(LAS f32x4*)(scr + h * 192 + 128 + lane * 8 + 4) = (f32x4){f[4], f[5], f[6], f[7]}; } }
        LDS_WAIT(); asm volatile("" ::: "memory");
        head_norm_rope_store(scr, cs, sn, knw, 1.0f, K + ((size_t)(b * NH + (lane >> 3)) * SEQ + s) * DQK, lane);
        LDS_WAIT(); asm volatile("" ::: "memory");
    }
#undef FQ_LOAD
}

__device__ __forceinline__ void rec_chunk32(Frame& F, const Args& args, int tok0) {
    const int lane = F.lane;
    const bf16_t* OFp = (const bf16_t*)(F.ws + WS_OF); const bf16_t* OBp = (const bf16_t*)(F.ws + WS_OB); const bf16_t* RG = (const bf16_t*)(F.ws + WS_RG); unsigned char* CAT = F.ws + WS_CAT;
    u32x4 n[4][6];
#pragma unroll
    for (int i = 0; i < 4; ++i) { const size_t o = (size_t)(tok0 + F.wave * 4 + i) * 1024 + lane * 16;
        n[i][0] = *(const u32x4*)(OFp + o); n[i][1] = *(const u32x4*)(OFp + o + 8); n[i][2] = *(const u32x4*)(OBp + o); n[i][3] = *(const u32x4*)(OBp + o + 8); n[i][4] = *(const u32x4*)(RG + o); n[i][5] = *(const u32x4*)(RG + o + 8); }
    float nw[16];
#pragma unroll
    for (int e = 0; e < 16; ++e) nw[e] = AIN(I_RNW)[(lane & 7) * 16 + e];
#pragma unroll
    for (int i = 0; i < 4; ++i) {
        float a[16], bb[16], g[16];
        unpack8(n[i][0], *(float(*)[8])a); unpack8(n[i][1], *(float(*)[8])(a + 8));
        unpack8(n[i][2], *(float(*)[8])bb); unpack8(n[i][3], *(float(*)[8])(bb + 8));
        unpack8(n[i][4], *(float(*)[8])g); unpack8(n[i][5], *(float(*)[8])(g + 8));
        float ss = 0.f;
#pragma unroll
        for (int e = 0; e < 16; ++e) { a[e] += bb[e]; ss += a[e] * a[e]; }
        ss += __shfl_xor(ss, 1); ss += __shfl_xor(ss, 2); ss += __shfl_xor(ss, 4);
        const float r = __builtin_amdgcn_rsqf(ss * (1.f / 128.f) + EPS);
#pragma unroll
        for (int e = 0; e < 16; ++e) a[e] = a[e] * r * nw[e] * siluf_(g[e]);
        u32x4 w8; w8.x = pk4_fp8(a[0], a[1], a[2], a[3]); w8.y = pk4_fp8(a[4], a[5], a[6], a[7]); w8.z = pk4_fp8(a[8], a[9], a[10], a[11]); w8.w = pk4_fp8(a[12], a[13], a[14], a[15]);
        *(u32x4*)(CAT + (size_t)(tok0 + F.wave * 4 + i) * 2048 + 1024 + lane * 16) = w8;
    }
}

__device__ __forceinline__ float wave_max_dpp(float v) {
#define WM_STEP(ctrl) v = fmaxf(v, __int_as_float(__builtin_amdgcn_update_dpp(__float_as_int(v), __float_as_int(v), ctrl, 0xF, 0xF, false)))
    WM_STEP(0xB1); WM_STEP(0x4E); WM_STEP(0x141); WM_STEP(0x140);
#undef WM_STEP
    const float r0 = __int_as_float(__builtin_amdgcn_readlane(__float_as_int(v), 0)), r1 = __int_as_float(__builtin_amdgcn_readlane(__float_as_int(v), 16));
    const float r2 = __int_as_float(__builtin_amdgcn_readlane(__float_as_int(v), 32)), r3 = __int_as_float(__builtin_amdgcn_readlane(__float_as_int(v), 48));
    return fmaxf(fmaxf(r0, r1), fmaxf(r2, r3));
}
__device__ __forceinline__ float wave_sum_dpp(float v) {
#define WS_STEP(ctrl) v += __int_as_float(__builtin_amdgcn_update_dpp(0, __float_as_int(v), ctrl, 0xF, 0xF, false))
    WS_STEP(0xB1); WS_STEP(0x4E); WS_STEP(0x141); WS_STEP(0x140);
#undef WS_STEP
    const float r0 = __int_as_float(__builtin_amdgcn_readlane(__float_as_int(v), 0)), r1 = __int_as_float(__builtin_amdgcn_readlane(__float_as_int(v), 16));
    const float r2 = __int_as_float(__builtin_amdgcn_readlane(__float_as_int(v), 32)), r3 = __int_as_float(__builtin_amdgcn_readlane(__float_as_int(v), 48));
    return (r0 + r1) + (r2 + r3);
}
__device__ __forceinline__ float grp8_max_dpp(float v) {
#define WM_STEP(ctrl) v = fmaxf(v, __int_as_float(__builtin_amdgcn_update_dpp(__float_as_int(v), __float_as_int(v), ctrl, 0xF, 0xF, false)))
    WM_STEP(0xB1); WM_STEP(0x4E); WM_STEP(0x141);
#undef WM_STEP
    return v;
}
__device__ __forceinline__ void route_topk(Frame& F, const Args& args) {
    const int gw = F.bid * NWAVES + F.wave, NGW = F.G * NWAVES, lane = F.lane;
    const float* logit = (const float*)(F.ws + WS_LOGIT); int* elist = (int*)(F.ws + WS_ELIST); int* slot_ep = (int*)(F.ws + WS_SLOTEP); float* slot_w = (float*)(F.ws + WS_SLOTW);
    const float bias = AIN(I_RBIAS)[lane]; const int g = lane >> 3;
    const float NEG = -__builtin_inff();
    LAS unsigned* hist = (LAS unsigned*)F.lds; LAS unsigned* hbase = hist + 64;
    for (int tok0 = gw; tok0 < T; tok0 += 8 * NGW) {
        if (F.tid < 64) hist[F.tid] = 0u;
        __syncthreads();
        float wv[8]; int erv[8]; unsigned lpv[8]; float lg[8];
#pragma unroll
        for (int i = 0; i < 8; ++i) { const int tok = tok0 + i * NGW; const size_t li = (size_t)(tok < T ? tok : 0) * 64 + lane;
            lg[i] = (logit[li] + logit[li + (size_t)T * 64]) + (logit[li + (size_t)2 * T * 64] + logit[li + (size_t)3 * T * 64]); }
#pragma unroll 1
        for (int i = 0; i < 8; ++i) { const int tok = tok0 + i * NGW; float w_ = 0.f; int er_ = -1; unsigned lp_ = 0u;
          float lgi = lg[0];
#pragma unroll
          for (int q = 1; q < 8; ++q) lgi = (q == i) ? lg[q] : lgi;
          if (tok < T) {
            float sc = sigmoidf_(lgi); sc = (sc == sc) ? sc : 0.5f;
            const float sel = sc + bias;
            const float m1 = grp8_max_dpp(sel);
            const unsigned long long bal = __ballot(sel == m1) & (0xFFull << (8 * g)); const int first = __builtin_ctzll(bal);
            const float m2 = grp8_max_dpp((lane == first) ? NEG : sel);
            const float gs = m1 + m2; int grank = 0;
#pragma unroll
            for (int j = 0; j < 8; ++j) { const float v = __int_as_float(__builtin_amdgcn_readlane(__float_as_int(gs), 8 * j)); grank += (v > gs || (v == gs && j < g)) ? 1 : 0; }
            const bool chosen = grank < TOPG; float rem = chosen ? sel : NEG; int er = TOPK;
#pragma unroll
            for (int k = 0; k < TOPK; ++k) { const float m = wave_max_dpp(rem); const int pick = __builtin_ctzll(__ballot(rem == m)); if (lane == pick) { er = k; rem = NEG; } }
            const bool selected = er < TOPK;
            const float sumw = wave_sum_dpp(selected ? sc : 0.f); w_ = sc / sumw * ROUTED_SCALE;
            if (selected) { er_ = er; lp_ = __hip_atomic_fetch_add(hist + lane, 1u, __ATOMIC_RELAXED, __HIP_MEMORY_SCOPE_WORKGROUP); }
            if (lane == 0) elist[(size_t)64 * 16384 + tok] = tok * 8;
          }
#pragma unroll
          for (int q = 0; q < 8; ++q) if (q == i) { wv[q] = w_; erv[q] = er_; lpv[q] = lp_; }
        }
        __syncthreads();
        if (F.tid < 64) { const unsigned c = hist[F.tid]; hbase[F.tid] = c ? __hip_atomic_fetch_add((unsigned*)(F.ctl + CW_CNT + 64 * F.tid), c, RLX_AGENT) : 0u; }
        __syncthreads();
        const unsigned base = hbase[lane];
#pragma unroll
        for (int i = 0; i < 8; ++i) { const int tok = tok0 + i * NGW;
            if (erv[i] >= 0) { const unsigned pos = base + lpv[i]; elist[(size_t)lane * 16384 + pos] = tok * 8 + erv[i]; slot_ep[tok * 8 + erv[i]] = (lane << 16) | (int)pos; slot_w[tok * 8 + erv[i]] = wv[i]; } }
        __syncthreads();
    }
}

__device__ __forceinline__ void moe_combine(Frame& F, const Args& args) {
    const int gw = F.bid * NWAVES + F.wave, NGW = F.G * NWAVES, lane = F.lane;
    const unsigned char* Y = (const unsigned char*)(F.ws + WS_Y); const float* mod = (const float*)(F.ws + WS_MOD);
    const int* slot_ep = (const int*)(F.ws + WS_SLOTEP); const float* slot_w = (const float*)(F.ws + WS_SLOTW); const bf16_t* Y1 = (const bf16_t*)(F.ws + WS_Y1);
    const LAS int* ro = (const LAS int*)(F.lds + GTAB_OFF) + 132;
    const int sh0 = ro[64];
    for (int tok = gw; tok < T; tok += NGW) {
        const int b = tok >> 11;
        int myrow = 0; float myw = 0.f;
        if (lane < 8) { const int ep = slot_ep[tok * 8 + lane]; myrow = ro[ep >> 16] + (ep & 0xffff); myw = slot_w[tok * 8 + lane]; }
        int rows[8]; float wk[8];
#pragma unroll
        for (int k = 0; k < 8; ++k) { rows[k] = __shfl(myrow, k); wk[k] = __shfl(myw, k); }
#pragma unroll
        for (int j = 0; j < 4; ++j) { const int col = j * 512 + lane * 8; float acc[8];
#pragma unroll
            for (int e = 0; e < 8; ++e) acc[e] = 0.f;
            u32x2 yv[9];
            yv[8] = *(const u32x2*)(Y + (size_t)(sh0 + tok) * DM + col);
#pragma unroll
            for (int k = 0; k < 8; ++k) yv[k] = *(const u32x2*)(Y + (size_t)rows[k] * DM + col);
#pragma unroll
            for (int k = 0; k < 8; ++k) { float t8[8];
#pragma unroll
                for (int e = 0; e < 8; ++e) t8[e] = 0.f;
                add_fp8x8(yv[k], t8);
#pragma unroll
                for (int e = 0; e < 8; ++e) acc[e] += wk[k] * t8[e]; }
            add_fp8x8(yv[8], acc);
            float* op = F.out + (size_t)tok * DM + col; const float* gp = mod + b * 12288 + 10240 + col;
            const u32x4 yw = *(const u32x4*)(Y1 + (size_t)tok * DM + col);
            const f32x4 g0 = *(const f32x4*)gp, g1 = *(const f32x4*)(gp + 4);
            *(f32x4*)op = (f32x4){bf_lo(yw.x), bf_hi(yw.x), bf_lo(yw.y), bf_hi(yw.y)} + g0 * (f32x4){acc[0], acc[1], acc[2], acc[3]};
            *(f32x4*)(op + 4) = (f32x4){bf_lo(yw.z), bf_hi(yw.z), bf_lo(yw.w), bf_hi(yw.w)} + g1 * (f32x4){acc[4], acc[5], acc[6], acc[7]}; }
    }
}
namespace att {
constexpr int KT_BYTES = 64 * 192, VT_BYTES = 64 * 256;
constexpr int L_K = 0, L_V = 2 * KT_BYTES, L_WS = L_V + 2 * VT_BYTES, L_END = L_WS + 8 * 256;
constexpr float THR = 8.f * 1.4426950408889634f;
#define ATT_SBAR() __builtin_amdgcn_sched_barrier(0)
__device__ __forceinline__ int crow(int r, int hi) { return (r & 3) + 8 * (r >> 2) + 4 * hi; }
__device__ __forceinline__ int kswz(int row, int chunk) { return row * 192 + (((chunk & ~3) | ((chunk & 3) ^ ((row >> 2) & 3))) << 4); }
typedef int v8i_a __attribute__((ext_vector_type(8)));
__device__ __forceinline__ void partialSM(f32x16& p0, f32x16& p1, float& m_reg, float& mn, float& alpha) {
    float pmax = fmaxf(p0[0], p1[0]);
#pragma unroll
    for (int r = 1; r < 16; r += 2) pmax = __builtin_fmaxf(__builtin_fmaxf(pmax, p0[r]), p0[r + 1 < 16 ? r + 1 : r]);
#pragma unroll
    for (int r = 1; r < 16; r += 2) pmax = __builtin_fmaxf(__builtin_fmaxf(pmax, p1[r]), p1[r + 1 < 16 ? r + 1 : r]);
    { auto rr = __builtin_amdgcn_permlane32_swap(__float_as_uint(pmax), __float_as_uint(pmax), false, false); pmax = fmaxf(__uint_as_float(rr[0]), __uint_as_float(rr[1])); }
    if (__builtin_expect(__all(pmax <= THR), 1)) { mn = 0.f; alpha = 1.f;
#pragma unroll
        for (int r = 0; r < 16; ++r) p0[r] = __builtin_amdgcn_exp2f(p0[r]);
    } else { mn = fmaxf(pmax, 0.f); alpha = __builtin_amdgcn_exp2f(-mn); m_reg += mn;
#pragma unroll
        for (int r = 0; r < 16; ++r) p0[r] = __builtin_amdgcn_exp2f(p0[r] - mn);
    }
}
__device__ __forceinline__ void finishSM(f32x16& p0, f32x16& p1, float mn, float alpha, float& l_reg, bf16x8& pa0, bf16x8& pa1, bf16x8& pa2, bf16x8& pa3) {
    if (__builtin_expect(__all(mn == 0.f), 1)) {
#pragma unroll
        for (int r = 0; r < 16; ++r) p1[r] = __builtin_amdgcn_exp2f(p1[r]);
    } else {
#pragma unroll
        for (int r = 0; r < 16; ++r) p1[r] = __builtin_amdgcn_exp2f(p1[r] - mn);
    }
    float ps = 0;
#pragma unroll
    for (int r = 0; r < 16; ++r) ps += p0[r];
#pragma unroll
    for (int r = 0; r < 16; ++r) ps += p1[r];
    { auto rr = __builtin_amdgcn_permlane32_swap(__float_as_uint(ps), __float_as_uint(ps), false, false); ps = __uint_as_float(rr[0]) + __uint_as_float(rr[1]); }
    l_reg = l_reg * alpha + ps;
#define ATT_PK4(P, BASE, OUT) do { unsigned a0 = cvt_pk_bf16(P[BASE + 0], P[BASE + 1]), a1 = cvt_pk_bf16(P[BASE + 2], P[BASE + 3]);   \
    unsigned b0 = cvt_pk_bf16(P[BASE + 4], P[BASE + 5]), b1 = cvt_pk_bf16(P[BASE + 6], P[BASE + 7]);                              \
    auto r0 = __builtin_amdgcn_permlane32_swap(a0, b0, false, false); auto r1 = __builtin_amdgcn_permlane32_swap(a1, b1, false, false); \
    u32x4 w = {r0[0], r1[0], r0[1], r1[1]}; OUT = *reinterpret_cast<bf16x8*>(&w); } while (0)
    ATT_PK4(p0, 0, pa0); ATT_PK4(p0, 8, pa1); ATT_PK4(p1, 0, pa2); ATT_PK4(p1, 8, pa3);
#undef ATT_PK4
}
__device__ __forceinline__ v8i_a ld32(const char* p0, const char* p1) { const u32x4 lo = *reinterpret_cast<const u32x4*>(p0), hi = *reinterpret_cast<const u32x4*>(p1); return (v8i_a){(int)lo.x, (int)lo.y, (int)lo.z, (int)lo.w, (int)hi.x, (int)hi.y, (int)hi.z, (int)hi.w}; }
__device__ __forceinline__ void qkt(f32x16& p0, f32x16& p1, const char* Ks, const v8i_a* qr, int r32, int hi, float m_reg) {
    const float c0 = -m_reg;
#pragma unroll
    for (int r = 0; r < 16; ++r) { p0[r] = c0; p1[r] = c0; }
#pragma unroll
    for (int s = 0; s < 3; ++s) { const int ch = 4 * s + 2 * hi;
        const v8i_a a0 = ld32(Ks + kswz(r32, ch), Ks + kswz(r32, ch + 1)), a1 = ld32(Ks + kswz(32 + r32, ch), Ks + kswz(32 + r32, ch + 1));
        p0 = __builtin_amdgcn_mfma_scale_f32_32x32x64_f8f6f4(a0, qr[s], p0, 0, 0, 0, 0, 0, 0);
        p1 = __builtin_amdgcn_mfma_scale_f32_32x32x64_f8f6f4(a1, qr[s], p1, 0, 0, 0, 0, 0, 0); }
}
__device__ __forceinline__ int v_rd_base(int lane) { return ((lane & 3) << 3) | (((lane >> 2) & 3) << 6) | (((lane >> 4) & 1) << 5) | (((lane >> 5) & 1) << 8); }
constexpr int v_rd_off(int d0, int ks, int half) { return d0 * 512 + ks * 4096 + half * 2048; }
template <int OFF> __device__ __forceinline__ s16x4 tr_read(int vb) { s16x4 r; asm volatile("ds_read_b64_tr_b16 %0, %1 offset:%2" : "=&v"(r) : "v"(vb), "i"(OFF) : "memory"); return r; }
template <int D0> __device__ __forceinline__ void pv_one(f32x16& od, int vb, bf16x8 pa0, bf16x8 pa1, bf16x8 pa2, bf16x8 pa3) {
    const s16x4 l0 = tr_read<v_rd_off(D0, 0, 0)>(vb), h0 = tr_read<v_rd_off(D0, 0, 1)>(vb), l1 = tr_read<v_rd_off(D0, 1, 0)>(vb), h1 = tr_read<v_rd_off(D0, 1, 1)>(vb);
    const s16x4 l2 = tr_read<v_rd_off(D0, 2, 0)>(vb), h2 = tr_read<v_rd_off(D0, 2, 1)>(vb), l3 = tr_read<v_rd_off(D0, 3, 0)>(vb), h3 = tr_read<v_rd_off(D0, 3, 1)>(vb);
    asm volatile("s_waitcnt lgkmcnt(0)" ::: "memory"); ATT_SBAR();
#define ATT_PK(L, H) (bf16x8){L[0], L[1], L[2], L[3], H[0], H[1], H[2], H[3]}
    od = __builtin_amdgcn_mfma_f32_32x32x16_bf16(pa0, ATT_PK(l0, h0), od, 0, 0, 0);
    od = __builtin_amdgcn_mfma_f32_32x32x16_bf16(pa1, ATT_PK(l1, h1), od, 0, 0, 0);
    od = __builtin_amdgcn_mfma_f32_32x32x16_bf16(pa2, ATT_PK(l2, h2), od, 0, 0, 0);
    od = __builtin_amdgcn_mfma_f32_32x32x16_bf16(pa3, ATT_PK(l3, h3), od, 0, 0, 0);
#undef ATT_PK
}
__device__ __forceinline__ void pv_d0(f32x16* o, int vb, bf16x8 pa0, bf16x8 pa1, bf16x8 pa2, bf16x8 pa3) {
    pv_one<0>(o[0], vb, pa0, pa1, pa2, pa3); pv_one<1>(o[1], vb, pa0, pa1, pa2, pa3); pv_one<2>(o[2], vb, pa0, pa1, pa2, pa3); pv_one<3>(o[3], vb, pa0, pa1, pa2, pa3);
}
__device__ __forceinline__ void attn_unit(const unsigned char* __restrict__ Qb, const unsigned char* __restrict__ Kh, const bf16_t* __restrict__ Vh, bf16_t* __restrict__ Ob, int ldo, char* lds) {
    int tid = threadIdx.x; asm volatile("" : "+v"(tid));
    const int wid = __builtin_amdgcn_readfirstlane(tid >> 6), lane = tid & 63, r32 = lane & 31, hi = lane >> 5;
    char* K_lds = lds + L_K; char* V_lds = lds + L_V;
    float* ws = (float*)(lds + L_WS) + wid * 64; float* li_l = ws; float* al_l = ws + 32;
    float m_reg = 0.f, l_reg = 0; f32x16 o[4] = {}; v8i_a qr[3];
    const char* Qw = (const char*)Qb + (size_t)(wid * 32 + r32) * DQK + hi * 32;
#pragma unroll
    for (int s = 0; s < 3; ++s) qr[s] = ld32(Qw + s * 64, Qw + s * 64 + 16);
    const int vb0 = (int)(uintptr_t)(LAS char*)(V_lds) + v_rd_base(lane);
#define ATT_DMA_K(t, b) do { const char* _g = (const char*)Kh + (size_t)(t) * KT_BYTES; int _ln = lane; asm volatile("" : "+v"(_ln)); _Pragma("unroll") for (int _i = 0; _i < 2; ++_i) { \
        if (_i * 8 + wid < 12) { const int _p = (_i * 8 + wid) * 64 + _ln, _row = _p / 12, _cp = _p % 12, _c = (_cp & ~3) | ((_cp & 3) ^ ((_row >> 2) & 3)); \
        __builtin_amdgcn_global_load_lds((const unsigned*)(_g + (unsigned)(_row * 192 + _c * 16)), (LAS unsigned*)(K_lds + (b) * KT_BYTES + (_i * 8 + wid) * 1024), 16, 0, 0); } } } while (0)
#define ATT_DMA_V(t, b) do { const char* _g = (const char*)Vh + (size_t)(t) * VT_BYTES; int _ln = lane; asm volatile("" : "+v"(_ln)); _Pragma("unroll") for (int _i = 0; _i < 2; ++_i) { \
        const int _off = ((_i * 8 + wid) * 64 + _ln) * 16, _sub = _off >> 9, _within = _off & 511, _kk = (_sub >> 2) * 8 + (_within >> 6), _k = (_kk & ~0xC) | ((_kk & 4) << 1) | ((_kk & 8) >> 1), _c = (_sub & 3) * 32 + ((_within & 63) >> 1); \
        __builtin_amdgcn_global_load_lds((const unsigned*)(_g + (unsigned)(_k * 256 + _c * 2)), (LAS unsigned*)(V_lds + (b) * VT_BYTES + (_i * 8 + wid) * 1024), 16, 0, 0); } } while (0)
#define ATT_WB() do { asm volatile("s_waitcnt vmcnt(0)" ::: "memory"); __builtin_amdgcn_s_barrier(); asm volatile("" ::: "memory"); } while (0)
#define ATT_RESC(a) do { if (__any((a) < 1.f)) { if (hi == 0) al_l[r32] = (a); asm volatile("s_waitcnt lgkmcnt(0)" ::: "memory"); \
    _Pragma("unroll") for (int d = 0; d < 4; ++d) _Pragma("unroll") for (int r = 0; r < 16; ++r) o[d][r] *= al_l[crow(r, hi)]; } } while (0)
    f32x16 pA0, pA1, pB0, pB1; float mnA, mnB, alA, alB; bf16x8 pa0, pa1, pa2, pa3; constexpr int NT = SEQ / 64;
    ATT_DMA_K(0, 0); ATT_WB();
    ATT_DMA_K(1, 1); ATT_DMA_V(0, 0);
    qkt(pA0, pA1, K_lds, qr, r32, hi, m_reg); partialSM(pA0, pA1, m_reg, mnA, alA);
    ATT_WB();
    for (int j = 1; j + 1 < NT; j += 2) {
        ATT_DMA_K(j + 1, 0); ATT_DMA_V(j, 1);
        ATT_SBAR(); qkt(pB0, pB1, K_lds + KT_BYTES, qr, r32, hi, m_reg);
        finishSM(pA0, pA1, mnA, alA, l_reg, pa0, pa1, pa2, pa3); ATT_SBAR();
        pv_d0(o, vb0, pa0, pa1, pa2, pa3); partialSM(pB0, pB1, m_reg, mnB, alB);
        ATT_RESC(alB); ATT_WB();
        ATT_DMA_K(j + 2, 1); ATT_DMA_V(j + 1, 0);
        ATT_SBAR(); qkt(pA0, pA1, K_lds, qr, r32, hi, m_reg);
        finishSM(pB0, pB1, mnB, alB, l_reg, pa0, pa1, pa2, pa3); ATT_SBAR();
        pv_d0(o, vb0 + VT_BYTES, pa0, pa1, pa2, pa3); partialSM(pA0, pA1, m_reg, mnA, alA);
        ATT_RESC(alA); ATT_WB();
    }
    ATT_DMA_V(NT - 1, 1);
    ATT_SBAR(); qkt(pB0, pB1, K_lds + KT_BYTES, qr, r32, hi, m_reg);
    finishSM(pA0, pA1, mnA, alA, l_reg, pa0, pa1, pa2, pa3); ATT_SBAR();
    pv_d0(o, vb0, pa0, pa1, pa2, pa3); partialSM(pB0, pB1, m_reg, mnB, alB);
    ATT_RESC(alB); ATT_WB();
    finishSM(pB0, pB1, mnB, alB, l_reg, pa0, pa1, pa2, pa3); ATT_SBAR();
    pv_d0(o, vb0 + VT_BYTES, pa0, pa1, pa2, pa3);
    if (hi == 0) li_l[r32] = l_reg; asm volatile("s_waitcnt lgkmcnt(0)" ::: "memory");
    float rli[16];
#pragma unroll
    for (int r = 0; r < 16; ++r) rli[r] = __builtin_amdgcn_rcpf(li_l[crow(r, hi)]);
    __builtin_amdgcn_s_barrier(); asm volatile("" ::: "memory");
    unsigned char* st = (unsigned char*)(lds + wid * 4096);
#pragma unroll
    for (int r = 0; r < 16; ++r) { const int orow = crow(r, hi);
#pragma unroll
        for (int d0 = 0; d0 < 4; ++d0) { const float v = o[d0][r] * rli[r]; st[orow * 128 + d0 * 32 + r32] = (unsigned char)(__builtin_amdgcn_cvt_pk_fp8_f32(v, v, 0, false) & 0xff); } }
    asm volatile("s_waitcnt lgkmcnt(0)" ::: "memory");
#pragma unroll
    for (int i = 0; i < 4; ++i) { const int q = i * 64 + lane, row = q >> 3, c = q & 7;
        *(u32x4*)((unsigned char*)Ob + (size_t)(wid * 32 + row) * ldo + c * 16) = *(const u32x4*)(st + row * 128 + c * 16); }
    asm volatile("s_waitcnt lgkmcnt(0)" ::: "memory"); __builtin_amdgcn_s_barrier(); asm volatile("" ::: "memory");
#undef ATT_DMA_K
#undef ATT_DMA_V
#undef ATT_WB
#undef ATT_RESC
}
}

namespace hg {
constexpr int O_QT = 0, O_KT = 16384, O_QD = 32768, O_KTT = 49152, O_VT = 65536, O_AM = 81920, O_ST = 90112, O_PART = 122880, O_SL = 126976, O_SP = 127488;
__device__ __forceinline__ int sw256(int row, int cb) { return row * 256 + (cb ^ ((row & 15) << 4)); }
__device__ __forceinline__ int sw128(int row, int cb) { return row * 128 + (cb ^ (((row >> 1) & 7) << 4)); }
__device__ __forceinline__ bf16x8 ld8(LAS unsigned char* p) { return *(const LAS bf16x8*)p; }
__device__ __forceinline__ void hgrn_chain(LAS unsigned char* lds, unsigned char* ws, const float* lb_fwd, const float* lb_bwd, int chain) {
    const int b = chain >> 4, h = (chain >> 1) & 7, dir = chain & 1;
    const bf16_t* RQ = (const bf16_t*)(ws + WS_RQ); const bf16_t* RZ = (const bf16_t*)(ws + (dir ? WS_RFB : WS_RFF)); const bf16_t* RI = (const bf16_t*)(ws + WS_RI);
    bf16_t* O = (bf16_t*)(ws + (dir ? WS_OB : WS_OF));
    int tid = threadIdx.x; asm volatile("" : "+v"(tid));
    const int wid = __builtin_amdgcn_readfirstlane(tid >> 6), lane = tid & 63, r32 = lane & 31, hi = lane >> 5;
    const int k0 = 2 * lane;
    const float* lbp = dir ? lb_bwd : lb_fwd;
    const float lb0 = sigmoidf_(lbp[h * 128 + k0] - lbp[1024 + h * 128 + k0]), lb1 = sigmoidf_(lbp[h * 128 + k0 + 1] - lbp[1024 + h * 128 + k0 + 1]);
    LAS float* PART = (LAS float*)(lds + O_PART); LAS float* SL = (LAS float*)(lds + O_SL); LAS float* SP = (LAS float*)(lds + O_SP);
    for (int i = tid; i < 32768 / 16; i += 512) ((LAS u32x4*)(lds + O_ST))[i] = (u32x4){0u, 0u, 0u, 0u};
    f32x16 S0 = {}, S1 = {};
    unsigned zc[8], qc[8]; u32x4 va, vb;
    const size_t colbase = (size_t)h * 128;
    const int ipair = tid >> 4, c16 = tid & 15;
#define HG_TT(c, i) (dir ? (2047 - (64 * (c) + (i))) : (64 * (c) + (i)))
#define HG_LOAD(c) do { _Pragma("unroll") for (int s = 0; s < 8; ++s) { const size_t off = ((size_t)(b * 2048 + HG_TT(c, 8 * wid + s))) * 1024 + colbase + k0; zc[s] = *(const unsigned*)(RZ + off); qc[s] = *(const unsigned*)(RQ + off); } \
        va = *(const u32x4*)(RI + ((size_t)(b * 2048 + HG_TT(c, 2 * ipair))) * 1024 + colbase + c16 * 8); vb = *(const u32x4*)(RI + ((size_t)(b * 2048 + HG_TT(c, 2 * ipair + 1))) * 1024 + colbase + c16 * 8); } while (0)
    HG_LOAD(0);
    for (int c = 0; c < 32; ++c) {
        float Lp0[8], Lp1[8], kk0[8], kk1[8]; float run0 = 1.f, run1 = 1.f;
#pragma unroll
        for (int s = 0; s < 8; ++s) { const float f0 = lb0 + (1.0f - lb0) * sigmoidf_(bf_lo(zc[s])), f1 = lb1 + (1.0f - lb1) * sigmoidf_(bf_hi(zc[s]));
            run0 *= f0; run1 *= f1; Lp0[s] = run0; Lp1[s] = run1; kk0[s] = 1.0f - f0; kk1[s] = 1.0f - f1; }
        *(LAS f32x2*)(PART + wid * 128 + k0) = (f32x2){run0, run1};
        __syncthreads();
        { float pre0 = 1.f, pre1 = 1.f, p31_0 = 1.f, p31_1 = 1.f, pl0 = 1.f, pl1 = 1.f;
#pragma unroll
          for (int q = 0; q < 8; ++q) { const f32x2 t = *(const LAS f32x2*)(PART + q * 128 + k0); if (q < wid) { pre0 *= t.x; pre1 *= t.y; } if (q < 4) { p31_0 *= t.x; p31_1 *= t.y; } pl0 *= t.x; pl1 *= t.y; }
          const float r31_0 = __builtin_amdgcn_rcpf(fmaxf(p31_0, 1e-37f)), r31_1 = __builtin_amdgcn_rcpf(fmaxf(p31_1, 1e-37f));
          float kt0[8], kt1[8];
#pragma unroll
          for (int s = 0; s < 8; ++s) { const int i = 8 * wid + s; const float P0 = pre0 * Lp0[s], P1 = pre1 * Lp1[s];
              const float rP0 = __builtin_amdgcn_rcpf(fmaxf(P0, 1e-37f)), rP1 = __builtin_amdgcn_rcpf(fmaxf(P1, 1e-37f));
              const float q0 = bf_lo(qc[s]), q1 = bf_hi(qc[s]);
              const float qd0 = q0 * P0, qd1 = q1 * P1; kt0[s] = kk0[s] * (p31_0 * rP0); kt1[s] = kk1[s] * (p31_1 * rP1);
              const int ad = sw256(i, 4 * lane);
              *(LAS unsigned*)(lds + O_QT + ad) = cvt_pk_bf16(qd0 * r31_0, qd1 * r31_1); *(LAS unsigned*)(lds + O_KT + ad) = cvt_pk_bf16(kt0[s], kt1[s]); *(LAS unsigned*)(lds + O_QD + ad) = cvt_pk_bf16(qd0, qd1); }
          u32x4 w0, w1; w0.x = cvt_pk_bf16(kt0[0], kt0[1]); w0.y = cvt_pk_bf16(kt0[2], kt0[3]); w0.z = cvt_pk_bf16(kt0[4], kt0[5]); w0.w = cvt_pk_bf16(kt0[6], kt0[7]);
          w1.x = cvt_pk_bf16(kt1[0], kt1[1]); w1.y = cvt_pk_bf16(kt1[2], kt1[3]); w1.z = cvt_pk_bf16(kt1[4], kt1[5]); w1.w = cvt_pk_bf16(kt1[6], kt1[7]);
          *(LAS u32x4*)(lds + O_KTT + sw128(k0, 16 * wid)) = w0; *(LAS u32x4*)(lds + O_KTT + sw128(k0 + 1, 16 * wid)) = w1;
          if (wid == 0) { *(LAS f32x2*)(SL + k0) = (f32x2){pl0, pl1}; *(LAS f32x2*)(SP + k0) = (f32x2){pl0 * r31_0, pl1 * r31_1}; } }
        { const unsigned a4[4] = {va.x, va.y, va.z, va.w}, b4[4] = {vb.x, vb.y, vb.z, vb.w};
#pragma unroll
          for (int e = 0; e < 8; ++e) { const unsigned lo = (e & 1) ? (a4[e >> 1] >> 16) : (a4[e >> 1] & 0xffffu), hi16 = (e & 1) ? (b4[e >> 1] & 0xffff0000u) : (b4[e >> 1] << 16);
              *(LAS unsigned*)(lds + O_VT + sw128(c16 * 8 + e, 4 * ipair)) = lo | hi16; } }
        if (c + 1 < 32) HG_LOAD(c + 1);
        __syncthreads();
        if (wid < 4) { const int si = wid >> 1, ti = wid & 1; f32x16 a = {};
#pragma unroll
            for (int ks = 0; ks < 8; ++ks) { const int cb = (16 * ks + 8 * hi) * 2;
                a = __builtin_amdgcn_mfma_f32_32x32x16_bf16(ld8(lds + O_KT + sw256(32 * si + r32, cb)), ld8(lds + O_QT + sw256(32 * ti + r32, cb)), a, 0, 0, 0); }
            const int t = 32 * ti + r32;
#pragma unroll
            for (int q = 0; q < 4; ++q) { const int s0 = 32 * si + 8 * q + 4 * hi; float v[4];
#pragma unroll
                for (int j = 0; j < 4; ++j) v[j] = (s0 + j <= t) ? a[4 * q + j] : 0.f;
                u32x2 w; w.x = cvt_pk_bf16(v[0], v[1]); w.y = cvt_pk_bf16(v[2], v[3]); *(LAS u32x2*)(lds + O_AM + sw128(t, s0 * 2)) = w; } }
        const int vi = wid >> 1, ii = wid & 1; f32x16 oacc = {};
#pragma unroll
        for (int ks = 0; ks < 8; ++ks) { const int cb = (16 * ks + 8 * hi) * 2;
            oacc = __builtin_amdgcn_mfma_f32_32x32x16_bf16(ld8(lds + O_ST + sw256(32 * vi + r32, cb)), ld8(lds + O_QD + sw256(32 * ii + r32, cb)), oacc, 0, 0, 0); }
        const int ki = wid >> 1;
        float sl[16], sp[16];
#pragma unroll
        for (int r = 0; r < 16; ++r) { const int kr = 32 * ki + (r & 3) + 8 * (r >> 2) + 4 * hi; sl[r] = SL[kr]; sp[r] = SP[kr]; }
        { f32x16 P = {}; const int v2 = 2 * (wid & 1);
#pragma unroll
          for (int ks = 0; ks < 4; ++ks) { const int cb = (16 * ks + 8 * hi) * 2;
              P = __builtin_amdgcn_mfma_f32_32x32x16_bf16(ld8(lds + O_KTT + sw128(32 * ki + r32, cb)), ld8(lds + O_VT + sw128(32 * v2 + r32, cb)), P, 0, 0, 0); }
#pragma unroll
          for (int r = 0; r < 16; ++r) S0[r] = sl[r] * S0[r] + sp[r] * P[r]; }
        { f32x16 P = {}; const int v2 = 2 * (wid & 1) + 1;
#pragma unroll
          for (int ks = 0; ks < 4; ++ks) { const int cb = (16 * ks + 8 * hi) * 2;
              P = __builtin_amdgcn_mfma_f32_32x32x16_bf16(ld8(lds + O_KTT + sw128(32 * ki + r32, cb)), ld8(lds + O_VT + sw128(32 * v2 + r32, cb)), P, 0, 0, 0); }
#pragma unroll
          for (int r = 0; r < 16; ++r) S1[r] = sl[r] * S1[r] + sp[r] * P[r]; }
        __syncthreads();
#pragma unroll
        for (int ks = 0; ks < 4; ++ks) { const int cb = (16 * ks + 8 * hi) * 2;
            oacc = __builtin_amdgcn_mfma_f32_32x32x16_bf16(ld8(lds + O_VT + sw128(32 * vi + r32, cb)), ld8(lds + O_AM + sw128(32 * ii + r32, cb)), oacc, 0, 0, 0); }
        { const int i = 32 * ii + r32; const int tt = dir ? (2047 - (64 * c + i)) : (64 * c + i); bf16_t* orow = O + ((size_t)(b * 2048 + tt)) * 1024 + colbase + 32 * vi + 4 * hi;
#pragma unroll
          for (int q = 0; q < 4; ++q) { u32x2 w; w.x = cvt_pk_bf16(oacc[4 * q], oacc[4 * q + 1]); w.y = cvt_pk_bf16(oacc[4 * q + 2], oacc[4 * q + 3]); *(u32x2*)(orow + 8 * q) = w; } }
#pragma unroll
        for (int q = 0; q < 4; ++q) { const int k0 = 32 * ki + 8 * q + 4 * hi; const int v0 = 32 * (2 * (wid & 1)) + r32, v1 = v0 + 32;
            u32x2 w; w.x = cvt_pk_bf16(S0[4 * q], S0[4 * q + 1]); w.y = cvt_pk_bf16(S0[4 * q + 2], S0[4 * q + 3]); *(LAS u32x2*)(lds + O_ST + sw256(v0, k0 * 2)) = w;
            w.x = cvt_pk_bf16(S1[4 * q], S1[4 * q + 1]); w.y = cvt_pk_bf16(S1[4 * q + 2], S1[4 * q + 3]); *(LAS u32x2*)(lds + O_ST + sw256(v1, k0 * 2)) = w; }
#ifdef HG_EXTRA_BAR
        __syncthreads();
#endif
    }
    __syncthreads();
#undef HG_LOAD
#undef HG_TT
}
}
constexpr int N_PHASES = 14;

__device__ __forceinline__ void build_group_tab(Frame& F) {
    LAS int* tab = (LAS int*)(F.lds + GTAB_OFF);
    if (F.wave == 0) {
        const int c = (int)__hip_atomic_load((unsigned*)(F.ctl + CW_CNT + 64 * F.lane), RLX_AGENT);
        int ti = (c + 255) >> 8, ci = c;
#pragma unroll
        for (int o = 1; o < 64; o <<= 1) { const int a = __shfl_up(ti, o), b2 = __shfl_up(ci, o); if (F.lane >= o) { ti += a; ci += b2; } }
        tab[F.lane + 1] = ti; tab[66 + F.lane] = c; tab[132 + F.lane] = ci - c;
        if (F.lane == 63) { tab[65] = ti + T / 256; tab[66 + 64] = T; tab[132 + 64] = ci; }
        if (F.lane == 0) tab[0] = 0;
    }
    __syncthreads();
}

__global__ void __launch_bounds__(NWAVES * 64, 2) hymba_fwd(Args args) {
    extern __shared__ __attribute__((aligned(16))) unsigned char lds_raw[];
    Frame F;
    F.lds = (LAS unsigned char*)lds_raw;
    F.tid = threadIdx.x; F.lane = F.tid & 63; F.wave = __builtin_amdgcn_readfirstlane(F.tid >> 6);
    F.G = gridDim.x; F.bid = blockIdx.x;
    F.ws = args.ws; F.ctl = (gu32*)(args.ws + WS_CTL); F.out = args.out;
    for (int u = F.tid; u < (LDS_BYTES - LDSCTL_OFF) / 4; u += NWAVES * 64) ((LAS unsigned*)(F.lds + LDSCTL_OFF))[u] = 0u;
    __syncthreads();
    volatile LAS unsigned* MISC = (volatile LAS unsigned*)(F.lds + MISC_OFF);
    const int lo = args.ph_lo, hi = args.ph_hi;
    const bool fused = (hi - lo) > 1;
    XcdBarrier bar; bar.bar = (unsigned*)(F.ctl + CW_BAR); bar.x = 0; bar.st = nullptr;
    if (fused) bar = xcd_barrier_post((unsigned*)(F.ctl + CW_BAR), MISC + 8);
#ifndef PH_MASK
#define PH_MASK 0x3fff
#endif
#define IN(k) (((PH_MASK >> (k)) & 1) && lo <= (k) && (k) < hi)
#define SEAM(k) do { if (IN(k) && IN((k) + 1)) xcd_barrier(bar); { int _t = threadIdx.x; asm volatile("" : "+v"(_t)); F.tid = _t; F.lane = _t & 63; F.wave = __builtin_amdgcn_readfirstlane(_t >> 6); } } while (0)
    unsigned char* ws = args.ws;

#ifndef NCONV_BLOCKS
#define NCONV_BLOCKS 0
#endif
    if (IN(0)) { p0_prologue(F, args); convert_range(F, args, F.bid * NWAVES + F.wave, F.G * NWAVES, CV_NEXP, CV_NEXP + CV_NSMALL); } SEAM(0);
#if INPROJ_FP8
    if (IN(1)) { rms_mod_rows<false, false, true>(F, args, AIN(I_X), nullptr, AIN(I_N1W), 0, 2048, nullptr, ws + WS_H); } SEAM(1);
#else
    if (IN(1)) { rms_mod_rows<false, true, false>(F, args, AIN(I_X), nullptr, AIN(I_N1W), 0, 2048, (bf16_t*)(ws + WS_H), nullptr); } SEAM(1);
#endif
#if INPROJ_FP8
    if (IN(2)) { pg8::DenseOrder S; S.init(ws + WS_H, 2048, ws + WS_WIN, 2048, T, INCP, F.G, F.bid); EpiInProj E{ws, 1.0f / 32.0f}; pg8::gemm_phase<EpiInProj, pg8::DenseOrder, true, true, true>(F.lds, 2048, 2048, S, E); } SEAM(2);
#else
    if (IN(2)) { pg8::DenseOrder S; S.init(ws + WS_H, 4096, ws + WS_WIN, 4096, T, INCP, F.G, F.bid); EpiInProj E{ws, 1.0f}; pg8::gemm_phase<EpiInProj, pg8::DenseOrder, true, false>(F.lds, 4096, 4096, S, E); } SEAM(2);
#endif
    if (IN(3)) {
        { pg8::DenseOrder S; S.init(ws + WS_QLAT, 512, ws + WS_WUQ, 512, T, 1536, F.G, F.bid); EpiBf16 E{(bf16_t*)(ws + WS_QRAW), 1536, 1.0f / 16.0f}; pg8::gemm_phase<EpiBf16, pg8::DenseOrder, true, true, true>(F.lds, 512, 512, S, E); }
        { pg8::DenseOrder S; S.init(ws + WS_KVLAT, 512, ws + WS_WUKV, 512, T, 2048, F.G, F.bid); EpiBf16 E{(bf16_t*)(ws + WS_KVRAW), 2048, 1.0f}; pg8::gemm_phase<EpiBf16, pg8::DenseOrder>(F.lds, 512, 512, S, E); }
    } SEAM(3);
    if (IN(4)) { finalize_qkv(F, args); } SEAM(4);
    if (IN(5)) {
#ifndef NO_HGRN
        if (!(args.flags & 1)) for (int ch = F.bid; ch < 128; ch += F.G) { hg::hgrn_chain(F.lds, ws, AIN(I_LBF), AIN(I_LBB), ch);
            asm volatile("s_waitcnt vmcnt(0)" ::: "memory"); __syncthreads();
            if (threadIdx.x == 0) { __builtin_amdgcn_fence(__ATOMIC_RELEASE, "agent"); asm volatile("s_waitcnt vmcnt(0)" ::: "memory"); (void)__hip_atomic_fetch_add((unsigned*)(F.ctl + CW_HGDONE), 1u, RLX_AGENT); } }
#endif
#ifndef NCV
#define NCV 64
#endif
#define CV_CHUNKS ((CV_NEXP + 63) / 64)
#define CV_PULL() do { for (;;) { if (F.tid == 0) MISC[0] = __hip_atomic_fetch_add((unsigned*)(F.ctl + CW_CVQ), 1u, RLX_AGENT); \
            __syncthreads(); const unsigned c = MISC[0]; __syncthreads(); if (c >= (unsigned)CV_CHUNKS) break; \
            const int lo = (int)c * 64; convert_range(F, args, F.wave, NWAVES, lo, (lo + 64 < CV_NEXP) ? lo + 64 : CV_NEXP); } } while (0)
        if (!(args.flags & 1) && F.bid >= F.G - NCV) CV_PULL();
#ifndef NO_ATTN
        if (!(args.flags & 2)) { const unsigned x0 = xb_xcc_id() & 7u; unsigned k = 0;
          for (;;) {
            if (F.tid == 0) { unsigned u = 0xffffffffu;
                for (; k < 8u; ++k) { const unsigned y = (x0 + k) & 7u; const unsigned v = __hip_atomic_fetch_add((unsigned*)(F.ctl + CW_QUEUE + 16 * y), 1u, RLX_AGENT); if (v < 64u) { u = ((y + 8u * (v >> 3)) << 3) | (v & 7u); break; } }
                MISC[0] = u; }
            __syncthreads(); const unsigned u = MISC[0]; __syncthreads();
            if (u >= 512u) break;
            const int bh = (int)(u >> 3), qb = (int)(u & 7), b = bh >> 3, h = bh & 7;
            att::attn_unit(ws + WS_Q + ((size_t)bh * SEQ + qb * 256) * DQK, ws + WS_K + (size_t)bh * SEQ * DQK, (const bf16_t*)(ws + WS_V) + (size_t)bh * SEQ * DV,
                           (bf16_t*)(ws + WS_CAT + ((size_t)(b * SEQ + qb * 256)) * 2048 + h * 128), 2048, (char*)lds_raw);
          } }
#endif
        if (!(args.flags & 1)) { { int t = threadIdx.x; asm volatile("" : "+v"(t)); F.tid = t; F.lane = t & 63; F.wave = __builtin_amdgcn_readfirstlane(t >> 6); } CV_PULL(); }
        { int t = threadIdx.x; asm volatile("" : "+v"(t)); F.tid = t; F.lane = t & 63; F.wave = __builtin_amdgcn_readfirstlane(t >> 6); }
        if (F.tid == 0) { unsigned sp = 0; while (__hip_atomic_load((unsigned*)(F.ctl + CW_HGDONE), __ATOMIC_RELAXED, __HIP_MEMORY_SCOPE_AGENT) < 128u) { __builtin_amdgcn_s_sleep(8); if (++sp > (1u << 22)) break; }
            __builtin_amdgcn_fence(__ATOMIC_ACQUIRE, "agent"); }
        __syncthreads();
        for (;;) {
            if (F.tid == 0) MISC[0] = __hip_atomic_fetch_add((unsigned*)(F.ctl + CW_RECQ), 1u, RLX_AGENT);
            __syncthreads(); const unsigned c = MISC[0]; __syncthreads();
            if (c >= (unsigned)(T / 32)) break;
            rec_chunk32(F, args, (int)c * 32);
        }
    } SEAM(5);
    if (IN(7)) { pg8::DenseOrder S; S.init(ws + WS_CAT, 2048, ws + WS_WOUT, 2048, T, 2048, F.G, F.bid); EpiOutProj E{(bf16_t*)(ws + WS_Y1), (const float*)(ws + WS_MOD), 1.0f / 32.0f}; pg8::gemm_phase<EpiOutProj, pg8::DenseOrder, true, true, true>(F.lds, 2048, 2048, S, E); } SEAM(7);
    if (IN(8)) { rms_mod_rows<true, true, true, true>(F, args, AIN(I_X), (const bf16_t*)(ws + WS_Y1), AIN(I_N2W), 6144, 8192, (bf16_t*)(ws + WS_H), ws + WS_H8); } SEAM(8);
    if (IN(9)) { pg8::SplitKOrder S; S.A = (const char*)(ws + WS_H); S.Bt = (const char*)(ws + WS_WRT); S.lda2 = 4096; S.KS2 = 1024; S.nM = 64; S.nS = 4; S.nwg = 256; S.G = F.G; S.c = F.bid;
        EpiRouter E{(float*)(ws + WS_LOGIT)}; pg8::gemm_phase<EpiRouter, pg8::SplitKOrder>(F.lds, 1024, 4096, S, E); } SEAM(9);
    if (IN(10)) { route_topk(F, args); } SEAM(10);
    if (IN(11)) {
        build_group_tab(F); const LAS int* tab = (const LAS int*)(F.lds + GTAB_OFF);
        pg8::GroupedOrder<true, false, 2> S; S.A = (const char*)(ws + WS_H8); S.lda2 = 2048; S.Bt = (const char*)(ws + WS_WGU); S.bexp = (size_t)1024 * 2048; S.K2 = 2048;
        S.elist = (const int*)(ws + WS_ELIST); S.ewt = nullptr; S.tab = tab; S.tpl = tab[F.lane + 1]; S.total = __builtin_amdgcn_readfirstlane(tab[65]) << 2; S.G = F.G; S.c = F.bid;
        EpiGemm1 E{ws + WS_ACT}; pg8::gemm_phase<EpiGemm1, pg8::GroupedOrder<true, false, 2>, false, true, true>(F.lds, 2048, 2048, S, E);
    } SEAM(11);
    if (IN(12)) {
        build_group_tab(F); const LAS int* tab = (const LAS int*)(F.lds + GTAB_OFF);
        pg8::GroupedOrder<false, false, 3> S; S.A = (const char*)(ws + WS_ACT); S.lda2 = 512; S.Bt = (const char*)(ws + WS_WDN); S.bexp = (size_t)2048 * 512; S.K2 = 512;
        S.elist = nullptr; S.ewt = nullptr; S.tab = tab; S.tpl = tab[F.lane + 1]; S.total = __builtin_amdgcn_readfirstlane(tab[65]) << 3; S.G = F.G; S.c = F.bid;
        EpiGemm2 E{ws + WS_Y}; pg8::gemm_phase<EpiGemm2, pg8::GroupedOrder<false, false, 3>, false, true, true>(F.lds, 512, 512, S, E);
    } SEAM(12);
    if (IN(13)) { build_group_tab(F); moe_combine(F, args); }
#undef IN
#undef SEAM
}

#ifndef MK_FUSED
#define MK_FUSED 1
#endif
extern "C" void kernel_launch(void* const* d_in, const int* in_sizes, int n_in, void* d_out, int out_size, void* d_ws, size_t ws_size, hipStream_t stream) {
    static int grid = 0;
    if (grid == 0) {
        if (n_in != 26 || in_sizes[0] != T * DM || out_size != T * DM || ws_size < WS_END) { fprintf(stderr, "kernel_launch: unexpected shapes (n_in %d, in0 %d, out %d, ws %zu < %zu)\n", n_in, n_in > 0 ? in_sizes[0] : -1, out_size, ws_size, (size_t)WS_END); grid = -1; return; }
        int dev = 0, cus = 0, per_cu = 0;
        if (hipGetDevice(&dev) != hipSuccess || hipDeviceGetAttribute(&cus, hipDeviceAttributeMultiprocessorCount, dev) != hipSuccess) { grid = -1; return; }
        if (hipFuncSetAttribute((const void*)hymba_fwd, hipFuncAttributeMaxDynamicSharedMemorySize, LDS_BYTES) != hipSuccess) { fprintf(stderr, "kernel_launch: hipFuncSetAttribute failed\n"); grid = -1; return; }
        if (hipOccupancyMaxActiveBlocksPerMultiprocessor(&per_cu, (const void*)hymba_fwd, NWAVES * 64, LDS_BYTES) != hipSuccess || per_cu < 1) fprintf(stderr, "kernel_launch: occupancy query reports %d\n", per_cu);
        (void)hipGetLastError();
        grid = cus;
    }
    if (grid < 0) return;
    if (hipMemsetAsync((char*)d_ws + WS_CTL, 0, CTL_ZERO_BYTES, stream) != hipSuccess) return;
    Args a{};
    for (int i = 0; i < 26; ++i) a.in[i] = (const float*)d_in[i];
    a.out = (float*)d_out; a.ws = (unsigned char*)d_ws;
#if MK_FUSED
    a.ph_lo = 0; a.ph_hi = N_PHASES;
    hipLaunchKernelGGL(hymba_fwd, dim3(grid), dim3(NWAVES * 64), LDS_BYTES, stream, a);
#else
#ifndef PROBE_FLAGS
#define PROBE_FLAGS 0
#endif
#ifndef PROBE_REP_MASK
#define PROBE_REP_MASK 0
#endif
#ifndef PROBE_REPS
#define PROBE_REPS 1
#endif
    for (int p = 0; p < N_PHASES; ++p) { a.ph_lo = p; a.ph_hi = p + 1; hipLaunchKernelGGL(hymba_fwd, dim3(grid), dim3(NWAVES * 64), LDS_BYTES, stream, a);
        if ((PROBE_REP_MASK >> p) & 1) for (int rep = 0; rep < PROBE_REPS; ++rep) { if (p == 5) (void)hipMemsetAsync((char*)d_ws + WS_CTL + CW_QUEUE * 4, 0, 512, stream); if (p == 10) (void)hipMemsetAsync((char*)d_ws + WS_CTL + CW_CNT * 4, 0, 65 * 64 * 4, stream); a.flags = PROBE_FLAGS; hipLaunchKernelGGL(hymba_fwd, dim3(grid), dim3(NWAVES * 64), LDS_BYTES, stream, a); a.flags = 0; } }
#endif
    const hipError_t le = hipPeekAtLastError();
    if (le != hipSuccess) fprintf(stderr, "kernel_launch: launch failed: %s\n", hipGetErrorName(le));
}
```

```cpp
#include <hip/hip_runtime.h>
#include <cstdio>
#include <cstdint>

#ifndef INPROJ_FP8
#define INPROJ_FP8 1
#endif
#define GAS __attribute__((address_space(1)))
#define LAS __attribute__((address_space(3)))
typedef unsigned short bf16_t;
typedef short bf16x8 __attribute__((ext_vector_type(8)));
typedef short s16x4 __attribute__((ext_vector_type(4)));
typedef float f32x4 __attribute__((ext_vector_type(4)));
typedef float f32x2 __attribute__((ext_vector_type(2)));
typedef float f32x16 __attribute__((ext_vector_type(16)));
typedef unsigned u32x4 __attribute__((ext_vector_type(4)));
typedef unsigned u32x2 __attribute__((ext_vector_type(2)));
typedef GAS unsigned gu32;

constexpr int NB = 8, SEQ = 2048, DM = 2048, T = NB * SEQ;
constexpr int NH = 8, DQK = 192, DNOPE = 128, DROPE = 64, DV = 128;
constexpr int QLORA = 512, KVLORA = 256;
constexpr int RH = 8, RK = 128, RV = 128, RQK = 1024, RW = 1024, RCHUNK = 64;
constexpr int INC = 5952, INCP = 6144;
constexpr int NE = 64, TOPK = 8, NGRP = 8, TOPG = 4, ED = 512;
constexpr float EPS = 1e-6f, ROUTED_SCALE = 2.5f;

constexpr size_t MiB = 1u << 20;
constexpr size_t WS_CTL = 0, CTL_ZERO_BYTES = 1 * MiB;
constexpr size_t KiB = 1024;
constexpr size_t WS_MOD = 1 * MiB;
constexpr size_t WS_ELIST = 2 * MiB;
constexpr size_t WS_SLOTEP = 6 * MiB + 512 * KiB;
constexpr size_t WS_SLOTW = 7 * MiB + 512 * KiB;
constexpr size_t WS_WIN = 11 * MiB;
constexpr size_t WS_WUQ = 35 * MiB;
constexpr size_t WS_WUKV = 36 * MiB + 512 * KiB;
constexpr size_t WS_WRT = 37 * MiB + 512 * KiB;
constexpr size_t WS_WOUT = 38 * MiB + 512 * KiB;
constexpr size_t WS_WDN = 46 * MiB + 512 * KiB;
constexpr size_t WS_H = WS_WDN + 130 * MiB;
constexpr size_t WS_WGU = WS_H + 64 * MiB;
constexpr size_t WS_MIX = WS_WGU + 260 * MiB;
constexpr size_t WS_QLAT = WS_MIX;
constexpr size_t WS_KVLAT = WS_QLAT + 16 * MiB;
constexpr size_t WS_KROPE = WS_KVLAT + 8 * MiB;
constexpr size_t WS_RQ = WS_KROPE + 2 * MiB;
constexpr size_t WS_RFF = WS_RQ + 32 * MiB, WS_RFB = WS_RFF + 32 * MiB, WS_RI = WS_RFB + 32 * MiB, WS_RG = WS_RI + 32 * MiB;
constexpr size_t WS_QRAW = WS_RG + 32 * MiB;
constexpr size_t WS_KVRAW = WS_QRAW + 48 * MiB;
constexpr size_t WS_Q = WS_KVRAW + 64 * MiB;
constexpr size_t WS_K = WS_Q + 48 * MiB;
constexpr size_t WS_V = WS_K + 48 * MiB;
constexpr size_t WS_CAT = WS_V + 32 * MiB;
constexpr size_t WS_Y1 = WS_RFF;
constexpr size_t WS_H8 = WS_QRAW;
constexpr size_t WS_OF = WS_QRAW, WS_OB = WS_QRAW + 32 * MiB;
constexpr size_t WS_Y = WS_WGU;
constexpr size_t WS_ACT = WS_Y + 576 * MiB;
constexpr size_t WS_LOGIT = WS_ACT + 145 * MiB;
constexpr size_t WS_END = 1024 * MiB;
static_assert(WS_CAT + 64 * MiB <= WS_END && WS_LOGIT + 16 * MiB <= WS_END && WS_SLOTW + 512 * KiB <= WS_WIN && WS_ELIST + 65 * 64 * KiB <= WS_SLOTEP, "ws map");

constexpr int CW_TMO = 0, CW_CODE = 1;
constexpr int CW_BAR = 4096;
constexpr int CW_CNT = 16384;
constexpr int CW_QUEUE = 32768;
constexpr int CW_HGDONE = 32768 + 1024;
constexpr int CW_RECQ = 32768 + 1088;
constexpr int CW_CVQ = 32768 + 1152;

constexpr int RING_BYTES = 131072;
constexpr int LDSCTL_OFF = RING_BYTES, MISC_OFF = LDSCTL_OFF + 320;
constexpr int LDS_BYTES = 147456;
constexpr int NWAVES = 8;

#define RLX_AGENT __ATOMIC_RELAXED, __HIP_MEMORY_SCOPE_AGENT
#define LDS_WAIT() asm volatile("s_waitcnt lgkmcnt(0)" ::: "memory")
#define VM_WAIT() asm volatile("s_waitcnt vmcnt(0)" ::: "memory")
__device__ __forceinline__ unsigned cvt_pk_bf16(float lo, float hi) { unsigned r; asm volatile("v_cvt_pk_bf16_f32 %0, %1, %2" : "=v"(r) : "v"(lo), "v"(hi)); return r; }
__device__ __forceinline__ float bf_lo(unsigned w) { return __uint_as_float(w << 16); }
__device__ __forceinline__ float bf_hi(unsigned w) { return __uint_as_float(w & 0xffff0000u); }
__device__ __forceinline__ float bf2f(bf16_t b) { return __uint_as_float(((unsigned)b) << 16); }
__device__ __forceinline__ bf16_t f2bf(float f) { return (bf16_t)(cvt_pk_bf16(f, 0.f) & 0xffffu); }
__device__ __forceinline__ float wave_sum(float v) {
#pragma unroll
    for (int o = 1; o < 64; o <<= 1) v += __shfl_xor(v, o);
    return v;
}
__device__ __forceinline__ float sigmoidf_(float x) { return __builtin_amdgcn_rcpf(1.0f + __expf(-x)); }
__device__ __forceinline__ float siluf_(float x) { return x * __builtin_amdgcn_rcpf(1.0f + __expf(-x)); }
#define XB_TMO      128
#define XB_XCNT(j)  (256  + 64 * (j))
#define XB_XSUB(j)  (1280 + 64 * (j))
#define XB_XGEN(j)  (2304 + 64 * (j))
#define XB_TOP      3328
#define XB_TOPGEN   3392
#define XCD_BAR_WORDS 3456
#define XB_SPIN_CAP (1u << 18)

__device__ __forceinline__ unsigned xb_ld(unsigned* p)              { return __hip_atomic_load(p, __ATOMIC_RELAXED, __HIP_MEMORY_SCOPE_AGENT); }
__device__ __forceinline__ unsigned xb_add(unsigned* p, unsigned v) { return __hip_atomic_fetch_add(p, v, __ATOMIC_RELAXED, __HIP_MEMORY_SCOPE_AGENT); }
__device__ __forceinline__ unsigned xb_xcc_id() { return (unsigned)__builtin_amdgcn_s_getreg((3 << 11) | 20) & 0xFu; }
#define XB_SPIN(cond, bar) do { unsigned _sp = 0; while (cond) { __builtin_amdgcn_s_sleep(1); \
    if ((++_sp & 255u) == 0u) { if (xb_ld(&(bar)[XB_TMO])) break; if (_sp > XB_SPIN_CAP) { atomicAdd(&(bar)[XB_TMO], 1u); break; } } } } while (0)

struct XcdBarrier {
    unsigned* bar; unsigned x;
    volatile LAS unsigned* st;
};

__device__ __forceinline__ XcdBarrier xcd_barrier_post(unsigned* bar, volatile LAS unsigned* st) {
    XcdBarrier b; b.bar = bar; b.x = xb_xcc_id(); b.st = st;
    if (threadIdx.x == 0) (void)xb_add(&bar[XB_XCNT(b.x)], 1u);
    return b;
}
__device__ __forceinline__ void xcd_barrier_complete(unsigned* bar, unsigned x, unsigned& nloc, unsigned& nx) {
    const unsigned G = gridDim.x * gridDim.y * gridDim.z;
    unsigned sum, cnt, mine, sp = 0u;
    for (;;) {
        sum = 0u; cnt = 0u; mine = 0u;
#pragma unroll
        for (unsigned j = 0; j < 16; ++j) { const unsigned c = xb_ld(&bar[XB_XCNT(j)]); sum += c; cnt += (c > 0u) ? 1u : 0u; mine = (j == x) ? c : mine; }
        if (sum == G) break;
        __builtin_amdgcn_s_sleep(1);
        if ((++sp & 255u) == 0u) { if (xb_ld(&bar[XB_TMO])) break; if (sp > XB_SPIN_CAP) { atomicAdd(&bar[XB_TMO], 1u); break; } }
    }
    nloc = mine > 0u ? mine : 1u; nx = cnt > 0u ? cnt : 1u;
}

__device__ __forceinline__ void xcd_barrier(const XcdBarrier& b) {
    asm volatile("s_waitcnt vmcnt(0)" ::: "memory");
    __syncthreads();
    if (threadIdx.x == 0) {
        unsigned* bar = b.bar;
        __builtin_amdgcn_s_waitcnt(0);
        unsigned nloc = b.st[0], nx = b.st[1];
        if (nloc == 0u) { xcd_barrier_complete(bar, b.x, nloc, nx); b.st[0] = nloc; b.st[1] = nx; }
        const unsigned old = xb_add(&bar[XB_XSUB(b.x)], 1u);
        const unsigned gen = old / nloc;
        if (old + 1u == (gen + 1u) * nloc) {
            __builtin_amdgcn_fence(__ATOMIC_RELEASE, "agent");
            asm volatile("s_waitcnt vmcnt(0)" ::: "memory");
            const unsigned og = xb_add(&bar[XB_TOP], 1u);
            const unsigned tg = og / nx;
            if (og + 1u == (tg + 1u) * nx) xb_add(&bar[XB_TOPGEN], 1u);
            else XB_SPIN(xb_ld(&bar[XB_TOPGEN]) == tg, bar);
            __builtin_amdgcn_fence(__ATOMIC_ACQUIRE, "agent");
            xb_add(&bar[XB_XGEN(b.x)], 1u);
            asm volatile("s_waitcnt vmcnt(0)" ::: "memory");
        } else {
            XB_SPIN(xb_ld(&bar[XB_XGEN(b.x)]) == gen, bar);
            __builtin_amdgcn_fence(__ATOMIC_ACQUIRE, "agent");
            asm volatile("s_waitcnt vmcnt(0)" ::: "memory");
        }
    }
    __syncthreads();
}
namespace pg8 {
constexpr int BM = 256, BK = 64, HALF = 128, HTB = HALF * BK * 2, STAGE_BYTES = 8 * HTB, NXCD = 8, WGM = 8;
__host__ __device__ __forceinline__ int lds_byte(int r, int c) { const int st = (r >> 4) * 2 + (c >> 5), rr = r & 15, cc = c & 31, ob = rr * 64 + cc * 2; return st * 1024 + (ob ^ (((ob >> 9) & 1) << 5)); }
__host__ __device__ __forceinline__ void stage_rc(int b, int& R, int& C) { const int st = b / 1024, sb = b % 1024, swz = sb ^ (((sb >> 9) & 1) << 5); R = (st >> 1) * 16 + swz / 64; C = (st & 1) * 32 + (swz % 64) / 2; }
__host__ __device__ __forceinline__ int gray2(int x) { return x ^ (x >> 1); }
__host__ __device__ __forceinline__ int lds_byte8(int r, int cbyte) { const int st = (r >> 4) * 2 + (cbyte >> 6), rr = r & 15, ch = (cbyte & 63) >> 4; return st * 1024 + rr * 64 + ((ch ^ gray2(rr >> 2)) << 4) + (cbyte & 15); }
__host__ __device__ __forceinline__ void stage_rc8(int b, int& R, int& Cbyte) { const int st = b / 1024, sb = b % 1024, rr = sb / 64, slot = (sb % 64) >> 4; R = (st >> 1) * 16 + rr; Cbyte = (st & 1) * 64 + ((slot ^ gray2(rr >> 2)) << 4) + (sb & 15); }
__host__ __device__ __forceinline__ int perm32(int rho) { const int n = rho >> 4, i = rho & 15; return 8 * (i >> 2) + 4 * n + (i & 3); }

struct Unit { int pm, pn, e, mt, rows, row0; };

struct DenseOrder {
    static constexpr bool GATHER = false;
    const char* A; const char* Bt; int lda2  , K2  ; int nM, nN, nwg, G, c;
    __device__ void init(const void* A_, int ldaBytes, const void* Bt_, int ldbBytes, int M, int N, int G_, int c_) { A = (const char*)A_; Bt = (const char*)Bt_; lda2 = ldaBytes; K2 = ldbBytes; nM = M / BM; nN = N / BM; nwg = nM * nN; G = G_; c = c_; }
    __device__ __forceinline__ bool next(int i, Unit& u) const {
        const long L = (long)i * G + c; if (L >= nwg) return false;
        int wgid = (int)L; { const int q = nwg / NXCD, r = nwg % NXCD, xcd = wgid % NXCD, off = wgid / NXCD; wgid = (xcd < r ? xcd * (q + 1) : r * (q + 1) + (xcd - r) * q) + off; }
        const int nig = WGM * nN, gid = wgid / nig, fm = gid * WGM, gsz = (nM - fm) < WGM ? (nM - fm) : WGM;
        u.pm = fm + ((wgid % nig) % gsz); u.pn = (wgid % nig) / gsz; u.e = 0; u.mt = 0; u.rows = 256; u.row0 = u.pm * 256; return true;
    }
    __device__ __forceinline__ void meta_prefetch(const Unit&, int, LAS unsigned char*, int) const {}
    __device__ __forceinline__ void a_addr(const Unit& u, int, LAS unsigned char*, int R0, int Cb, const char*& base, unsigned (&ao)[4]) const {
        base = A + (size_t)u.pm * 256 * lda2;
#pragma unroll
        for (int j = 0; j < 4; ++j) ao[j] = (unsigned)((R0 + 64 * j) * lda2 + Cb);
    }
    __device__ __forceinline__ const char* b_addr(const Unit& u) const { return Bt + (size_t)u.pn * 256 * K2; }
    __device__ __forceinline__ size_t arow64() const { return (size_t)64 * lda2; }
};

struct SplitKOrder {
    static constexpr bool GATHER = false;
    const char* A; const char* Bt; int lda2, KS2  ; int nM, nS, nwg, G, c;
    __device__ __forceinline__ bool next(int i, Unit& u) const {
        const long L = (long)i * G + c; if (L >= nwg) return false;
        u.pm = (int)L / nS; u.pn = (int)L % nS; u.e = 0; u.mt = 0; u.rows = 256; u.row0 = u.pm * 256; return true;
    }
    __device__ __forceinline__ void meta_prefetch(const Unit&, int, LAS unsigned char*, int) const {}
    __device__ __forceinline__ void a_addr(const Unit& u, int, LAS unsigned char*, int R0, int Cb, const char*& base, unsigned (&ao)[4]) const {
        base = A + (size_t)u.pm * 256 * lda2 + (size_t)u.pn * KS2;
#pragma unroll
        for (int j = 0; j < 4; ++j) ao[j] = (unsigned)((R0 + 64 * j) * lda2 + Cb);
    }
    __device__ __forceinline__ const char* b_addr(const Unit& u) const { return Bt + (size_t)u.pn * KS2; }
    __device__ __forceinline__ size_t arow64() const { return (size_t)64 * lda2; }
};

typedef int v8i_t __attribute__((ext_vector_type(8)));
__device__ __forceinline__ int pg8_xor16(int a) { int r; asm volatile("v_xor_b32 %0, 16, %1" : "=v"(r) : "v"(a)); return r; }
struct Frag2 { u32x4 lo, hi; };
template <bool F8> struct FragSel { typedef Frag2 T; };
template <> struct FragSel<true> { typedef v8i_t T; };
template <class Epi, class Sched, bool ALIGN_EPI = true, bool FP8 = false, bool SWZ8 = false>
__device__ __forceinline__ void gemm_phase(LAS unsigned char* lds, const int Kb, const int ldbB, const Sched& S, const Epi& E) {
    int tid = threadIdx.x; asm volatile("" : "+v"(tid));
    const int wid = __builtin_amdgcn_readfirstlane(tid >> 6), lane = tid & 63, wr = wid >> 2, wc = wid & 3, fr = lane & 15, fq = lane >> 4;
    const int nt = Kb / 128;
    int R0, C0; if constexpr (FP8 && SWZ8) { int cb; stage_rc8(tid * 16, R0, cb); C0 = cb >> 1; } else stage_rc(tid * 16, R0, C0);
    unsigned voffB[2];
    { const int Rb = Epi::PERM ? (64 * (R0 >> 5) + 16 * ((R0 & 15) >> 2) + 4 * ((R0 >> 4) & 1) + (R0 & 3)) : R0; voffB[0] = (unsigned)(Rb * ldbB + C0 * 2); voffB[1] = voffB[0]; }
    const size_t pstepB = (size_t)(Epi::PERM ? 128 : 64) * ldbB;
    const size_t kstep = (size_t)(BK * 2);
    const size_t hstepB = (size_t)(Epi::PERM ? 8 : HALF) * ldbB;
    const unsigned ldsw = (unsigned)wid * 1024u;
    const int aoffL = (FP8 && SWZ8) ? lds_byte8(wr * 64 + fr, fq * 32) : (FP8 ? lds_byte(wr * 64 + fr, fq * 16) : lds_byte(wr * 64 + fr, fq * 8)), aoffH1k = FP8 ? aoffL + 16 : aoffL + 1024;
    int boffL = ((FP8 && SWZ8) ? lds_byte8(wc * 32 + fr, fq * 32) : (FP8 ? lds_byte(wc * 32 + fr, fq * 16) : lds_byte(wc * 32 + fr, fq * 8))) + 65536; asm volatile("" : "+v"(boffL)); const int boffH1k = FP8 ? boffL + 16 : boffL + 1024;
#define PG8_SA(b, h) (((b) * 2 + (h)) * HTB)
#define PG8_SB(b, h) ((4 + (b) * 2 + (h)) * HTB)
    const unsigned ldsb = (unsigned)__builtin_amdgcn_readfirstlane((int)(unsigned)(uintptr_t)lds) + ldsw;
#define PG8_DMA(gb, vo, ldst) asm volatile("s_mov_b32 m0, %2\n\ts_nop 0\n\tglobal_load_lds_dwordx4 %0, %1" :: "v"(vo), "s"(gb), "s"(ldst) : "memory")
#define PG8_STAGE(bufoff, gbase, voff) do { const char* _gb = (const char*)(gbase); _Pragma("unroll") for (int _i = 0; _i < 2; ++_i) PG8_DMA(_gb + (size_t)_i * pstepB, (voff)[0], ldsb + (unsigned)((bufoff) + _i * 8192)); } while (0)
#define PG8_STAGE_A(bufoff, gbase, aov, h) do { const char* _gb = (const char*)(gbase); _Pragma("unroll") for (int _i = 0; _i < 2; ++_i) { \
        if constexpr (Sched::GATHER) PG8_DMA(_gb, (aov)[(h) * 2 + _i], ldsb + (unsigned)((bufoff) + _i * 8192)); \
        else PG8_DMA(_gb + (size_t)((h) * 2 + _i) * S.arow64(), (aov)[0], ldsb + (unsigned)((bufoff) + _i * 8192)); } } while (0)
#define PG8_LDF(dst, off0, off1) do { const u32x4 _lo = *(const LAS u32x4*)(lds + (off0)), _hi = *(const LAS u32x4*)(lds + (off1)); \
        if constexpr (FP8) dst = (v8i_t){(int)_lo.x, (int)_lo.y, (int)_lo.z, (int)_lo.w, (int)_hi.x, (int)_hi.y, (int)_hi.z, (int)_hi.w}; else { dst.lo = _lo; dst.hi = _hi; } } while (0)
#define PG8_HI(lo, hi1k) ((FP8 && SWZ8) ? pg8_xor16(lo) : (hi1k))
#define PG8_LDA(dst, b, h) do { const int _hio = PG8_HI(aoffL, aoffH1k); _Pragma("unroll") for (int m = 0; m < 4; ++m) PG8_LDF(dst[m], PG8_SA(b, h) + aoffL + m * 2048, PG8_SA(b, h) + _hio + m * 2048); } while (0)
#define PG8_LDB(dst, b, h) do { const int _hio = PG8_HI(boffL, boffH1k); _Pragma("unroll") for (int n = 0; n < 2; ++n) PG8_LDF(dst[n], (PG8_SB(b, h) - 65536) + boffL + n * 2048, (PG8_SB(b, h) - 65536) + _hio + n * 2048); } while (0)
#define PG8_MMA(ai, bj, At, Bt) do { __builtin_amdgcn_s_setprio(1); _Pragma("unroll") for (int m = 0; m < 4; ++m) _Pragma("unroll") for (int n = 0; n < 2; ++n) { \
        if constexpr (FP8) acc[ai][bj][m][n] = __builtin_amdgcn_mfma_scale_f32_16x16x128_f8f6f4(Bt[n], At[m], acc[ai][bj][m][n], 0, 0, 0, 0, 0, 0);     \
        else { acc[ai][bj][m][n] = __builtin_amdgcn_mfma_f32_16x16x32_bf16(__builtin_bit_cast(bf16x8, Bt[n].lo), __builtin_bit_cast(bf16x8, At[m].lo), acc[ai][bj][m][n], 0, 0, 0); \
            acc[ai][bj][m][n] = __builtin_amdgcn_mfma_f32_16x16x32_bf16(__builtin_bit_cast(bf16x8, Bt[n].hi), __builtin_bit_cast(bf16x8, At[m].hi), acc[ai][bj][m][n], 0, 0, 0); } } \
        __builtin_amdgcn_s_setprio(0); } while (0)
#define PG8_LDA2(dst, b, h) do { const int _hio = PG8_HI(aoffL, aoffH1k); _Pragma("unroll") for (int m = 0; m < 2; ++m) PG8_LDF(dst[m], PG8_SA(b, h) + aoffL + m * 2048, PG8_SA(b, h) + _hio + m * 2048); } while (0)
#define PG8_MF(ai, bj, m, Av, Bt) do { _Pragma("unroll") for (int n = 0; n < 2; ++n) acc[ai][bj][m][n] = __builtin_amdgcn_mfma_scale_f32_16x16x128_f8f6f4(Bt[n], Av, acc[ai][bj][m][n], 0, 0, 0, 0, 0, 0); } while (0)
#define PG8_MMA8(ai, At, B0, B1, b, h) do { __builtin_amdgcn_s_setprio(1); const int _hio = PG8_HI(aoffL, aoffH1k); \
        PG8_MF(ai, 0, 0, At[0], B0); PG8_MF(ai, 1, 0, At[0], B1); PG8_LDF(At[0], PG8_SA(b, h) + aoffL + 2 * 2048, PG8_SA(b, h) + _hio + 2 * 2048); \
        PG8_MF(ai, 0, 1, At[1], B0); PG8_MF(ai, 1, 1, At[1], B1); PG8_LDF(At[1], PG8_SA(b, h) + aoffL + 3 * 2048, PG8_SA(b, h) + _hio + 3 * 2048); \
        PG8_MF(ai, 0, 2, At[0], B0); PG8_MF(ai, 1, 2, At[0], B1); PG8_MF(ai, 0, 3, At[1], B0); PG8_MF(ai, 1, 3, At[1], B1); __builtin_amdgcn_s_setprio(0); } while (0)
#define PG8_WAIT_V(n) asm volatile("s_waitcnt vmcnt(" #n ")" ::: "memory")
#define PG8_WAIT_L(n) asm volatile("s_waitcnt lgkmcnt(" #n ")" ::: "memory")
#define PG8_BAR __builtin_amdgcn_s_barrier()
#define PG8_SCHED __builtin_amdgcn_sched_barrier(0)
    Unit cur, nxt; int ui = 0;
    if (!S.next(0, cur)) return;
    f32x4 acc[2][2][4][2];
#pragma unroll
    for (int a = 0; a < 2; ++a)
#pragma unroll
        for (int b = 0; b < 2; ++b)
#pragma unroll
            for (int m = 0; m < 4; ++m)
#pragma unroll
                for (int n = 0; n < 2; ++n) acc[a][b][m][n] = (f32x4){0.f, 0.f, 0.f, 0.f};
    typename FragSel<FP8>::T At[4], B0[2], B1[2];
    const char* cA; unsigned cao[4]; const char* nA; unsigned nao[4];
    int mslot = 0;
    if constexpr (Sched::GATHER) { S.meta_prefetch(cur, 0, lds, wid); PG8_WAIT_V(0); __syncthreads(); }
    S.a_addr(cur, 0, lds, R0, C0 * 2, cA, cao);
    const char* cB = S.b_addr(cur);
    PG8_STAGE(PG8_SB(0, 0), cB, voffB); PG8_STAGE(PG8_SB(0, 1), cB + hstepB, voffB); PG8_STAGE_A(PG8_SA(0, 0), cA, cao, 0); PG8_STAGE_A(PG8_SA(0, 1), cA, cao, 1);
    if (wr == 1) PG8_BAR;
    PG8_WAIT_V(2); PG8_BAR;
    PG8_STAGE(PG8_SB(1, 0), cB + kstep, voffB); PG8_STAGE_A(PG8_SA(1, 0), cA + kstep, cao, 0); PG8_STAGE(PG8_SB(1, 1), cB + hstepB + kstep, voffB);
    PG8_WAIT_V(6); PG8_BAR;
    for (;;) {
        const bool has_next = S.next(ui + 1, nxt);
        const int nslot = (mslot == 2) ? 0 : mslot + 1;
        if constexpr (Sched::GATHER) { if (has_next) S.meta_prefetch(nxt, nslot, lds, wid); }
        const char* nB = has_next ? S.b_addr(nxt) : cB;
#pragma unroll 1
        for (int t = 0; t < nt; t += 2) {
            const bool last = (t == nt - 2);
            const char* a1 = cA + (size_t)(t + 1) * kstep;
            const char* b2 = last ? nB : cB + (size_t)(t + 2) * kstep;
            const char* b3 = b2 + kstep;
            if constexpr (FP8) {
            PG8_LDB(B0, 0, 0); PG8_LDB(B1, 0, 1); PG8_SCHED; PG8_LDA2(At, 0, 0); PG8_STAGE_A(PG8_SA(1, 1), a1, cao, 1);
            PG8_WAIT_V(8); PG8_WAIT_L(0); PG8_BAR; PG8_MMA8(0, At, B0, B1, 0, 0); PG8_BAR; PG8_SCHED;
            if (last) {
                if (has_next) { S.a_addr(nxt, nslot, lds, R0, C0 * 2, nA, nao); cA = nA;
#pragma unroll
                    for (int j = 0; j < 4; ++j) cao[j] = nao[j]; }
            }
            const char* a2 = last ? cA : cA + (size_t)(t + 2) * kstep;
            const char* a3 = a2 + kstep;
            PG8_LDA2(At, 0, 1); PG8_STAGE(PG8_SB(0, 0), b2, voffB); PG8_STAGE(PG8_SB(0, 1), b2 + hstepB, voffB); PG8_STAGE_A(PG8_SA(0, 0), a2, cao, 0);
            PG8_WAIT_V(8); PG8_WAIT_L(0); PG8_BAR; PG8_MMA8(1, At, B0, B1, 0, 1); PG8_BAR; PG8_SCHED;
            PG8_LDB(B0, 1, 0); PG8_LDB(B1, 1, 1); PG8_SCHED; PG8_LDA2(At, 1, 0); PG8_STAGE_A(PG8_SA(0, 1), a2, cao, 1);
            PG8_WAIT_V(8); PG8_WAIT_L(0); PG8_BAR; PG8_MMA8(0, At, B0, B1, 1, 0); PG8_BAR; PG8_SCHED;
            PG8_LDA2(At, 1, 1); PG8_STAGE(PG8_SB(1, 0), b3, voffB); PG8_STAGE(PG8_SB(1, 1), b3 + hstepB, voffB); PG8_STAGE_A(PG8_SA(1, 0), a3, cao, 0);
            PG8_WAIT_V(8); PG8_WAIT_L(0); PG8_BAR; PG8_MMA8(1, At, B0, B1, 1, 1); PG8_BAR; PG8_SCHED;
            } else {
            PG8_LDB(B0, 0, 0); PG8_LDB(B1, 0, 1); PG8_SCHED; PG8_LDA(At, 0, 0); PG8_STAGE_A(PG8_SA(1, 1), a1, cao, 1);
            PG8_WAIT_V(8); PG8_WAIT_L(0); PG8_BAR; PG8_MMA(0, 0, At, B0); PG8_MMA(0, 1, At, B1); PG8_BAR; PG8_SCHED;
            if (last) {
                if (has_next) { S.a_addr(nxt, nslot, lds, R0, C0 * 2, nA, nao); cA = nA;
#pragma unroll
                    for (int j = 0; j < 4; ++j) cao[j] = nao[j]; }
            }
            const char* a2 = last ? cA : cA + (size_t)(t + 2) * kstep;
            const char* a3 = a2 + kstep;
            PG8_LDA(At, 0, 1); PG8_STAGE(PG8_SB(0, 0), b2, voffB); PG8_STAGE(PG8_SB(0, 1), b2 + hstepB, voffB); PG8_STAGE_A(PG8_SA(0, 0), a2, cao, 0);
            PG8_WAIT_V(8); PG8_WAIT_L(0); PG8_BAR; PG8_MMA(1, 0, At, B0); PG8_MMA(1, 1, At, B1); PG8_BAR; PG8_SCHED;
            PG8_LDB(B0, 1, 0); PG8_LDB(B1, 1, 1); PG8_SCHED; PG8_LDA(At, 1, 0); PG8_STAGE_A(PG8_SA(0, 1), a2, cao, 1);
            PG8_WAIT_V(8); PG8_WAIT_L(0); PG8_BAR; PG8_MMA(0, 0, At, B0); PG8_MMA(0, 1, At, B1); PG8_BAR; PG8_SCHED;
            PG8_LDA(At, 1, 1); PG8_STAGE(PG8_SB(1, 0), b3, voffB); PG8_STAGE(PG8_SB(1, 1), b3 + hstepB, voffB); PG8_STAGE_A(PG8_SA(1, 0), a3, cao, 0);
            PG8_WAIT_V(8); PG8_WAIT_L(0); PG8_BAR; PG8_MMA(1, 0, At, B0); PG8_MMA(1, 1, At, B1); PG8_BAR; PG8_SCHED;
            }
        }
        if constexpr (ALIGN_EPI) { if (wr == 0) PG8_BAR; }
        E(acc, cur, mslot, lds, wr, wc, fr, fq);
        if (!has_next) break;
#pragma unroll
        for (int a = 0; a < 2; ++a)
#pragma unroll
            for (int b = 0; b < 2; ++b)
#pragma unroll
                for (int m = 0; m < 4; ++m)
#pragma unroll
                    for (int n = 0; n < 2; ++n) acc[a][b][m][n] = (f32x4){0.f, 0.f, 0.f, 0.f};
        cur = nxt; cB = nB; ++ui; mslot = nslot;
        if constexpr (ALIGN_EPI) { if (wr == 1) PG8_BAR; }
    }
    PG8_WAIT_V(0);
    if constexpr (!ALIGN_EPI) { if (wr == 0) PG8_BAR; }
    PG8_BAR;
#undef PG8_SA
#undef PG8_SB
#undef PG8_STAGE
#undef PG8_STAGE_A
#undef PG8_DMA
#undef PG8_LDA
#undef PG8_LDA2
#undef PG8_MF
#undef PG8_MMA8
#undef PG8_HI
#undef PG8_LDF
#undef PG8_LDB
#undef PG8_MMA
#undef PG8_WAIT_V
#undef PG8_WAIT_L
#undef PG8_BAR
#undef PG8_SCHED
}
}
constexpr int GTAB_OFF = LDSCTL_OFF + 1024;
constexpr int META_OFF = LDSCTL_OFF + 4096;
namespace pg8 {
template <bool GATHER_A, bool NEED_W, int NTSHIFT>
struct GroupedOrder {
    static constexpr bool GATHER = GATHER_A;
    const char* A; int lda2; const char* Bt; size_t bexp; int K2; const int* elist; const float* ewt; const LAS int* tab; int tpl; int total; int G, c;
    __device__ __forceinline__ bool next(int i, Unit& u) const {
        int mtg;
        if (G == 256) { constexpr int NT = 1 << NTSHIFT, RPX = 32 / NT;
            mtg = i * (256 / NT) + RPX * (c & 7) + (c >> (3 + NTSHIFT)); u.pn = (c >> 3) & (NT - 1); if (mtg >= (total >> NTSHIFT)) return false; }
        else { const long L = (long)i * G + c; if (L >= total) return false; mtg = (int)L >> NTSHIFT; u.pn = (int)L & ((1 << NTSHIFT) - 1); }
        const int e = __popcll(__ballot(tpl <= mtg));
        const int tpe = __builtin_amdgcn_readfirstlane(tab[e]), cn = __builtin_amdgcn_readfirstlane(tab[66 + e]), ro = __builtin_amdgcn_readfirstlane(tab[132 + e]);
        u.e = e; u.pm = 0; u.mt = mtg - tpe; const int rem = cn - u.mt * 256; u.rows = rem < 256 ? rem : 256; u.row0 = ro + u.mt * 256; return true;
    }
    __device__ __forceinline__ void meta_prefetch(const Unit& u, int slot, LAS unsigned char* lds, int wid) const {
        if (wid == 0) {
            const int lane = threadIdx.x & 63;
            __builtin_amdgcn_global_load_lds((const unsigned*)(elist + (size_t)u.e * 16384 + u.mt * 256 + lane * 4), (LAS unsigned*)(lds + META_OFF + slot * 2048), 16, 0, 0);
            if (NEED_W) __builtin_amdgcn_global_load_lds((const unsigned*)(ewt + (size_t)u.e * 16384 + u.mt * 256 + lane * 4), (LAS unsigned*)(lds + META_OFF + slot * 2048 + 1024), 16, 0, 0);
        }
    }
    __device__ __forceinline__ void a_addr(const Unit& u, int slot, LAS unsigned char* lds, int R0, int Cb, const char*& base, unsigned (&ao)[4]) const {
        if constexpr (GATHER_A) {
            base = A; const LAS int* me = (const LAS int*)(lds + META_OFF + slot * 2048);
#pragma unroll
            for (int j = 0; j < 4; ++j) { const int r = R0 + 64 * j; const int en = me[r]; const int tok = (r < u.rows) ? (en >> 3) : 0; ao[j] = (unsigned)tok * (unsigned)lda2 + (unsigned)Cb; }
        } else {
            base = A + (size_t)u.row0 * lda2;
#pragma unroll
            for (int j = 0; j < 4; ++j) ao[j] = (unsigned)((R0 + 64 * j) * lda2 + Cb);
        }
    }
    __device__ __forceinline__ const char* b_addr(const Unit& u) const { return Bt + (size_t)u.e * bexp + (size_t)u.pn * 256 * K2; }
    __device__ __forceinline__ size_t arow64() const { return (size_t)64 * lda2; }
};
}

typedef f32x4 Acc[2][2][4][2];
__device__ __forceinline__ unsigned pk4_fp8(float a, float b, float c, float d);

struct EpiInProj {
    static constexpr bool PERM = true;
    unsigned char* ws; float oscale;
    __device__ __forceinline__ void operator()(const Acc& acc, const pg8::Unit& u, int, LAS unsigned char*, int wr, int wc, int fr, int fq) const {
        asm volatile("" : "+v"(fr), "+v"(fq));
        bf16_t* base; int ld, c0, ncv = 256;
        const int pn = u.pn;
        const int row0 = u.pm * 256 + wr * 64 + fr, colw = wc * 64 + 16 * fq;
        if (pn < 2) {
            unsigned char* q8 = ws + WS_QLAT;
#pragma unroll
            for (int ai = 0; ai < 2; ++ai)
#pragma unroll
                for (int m = 0; m < 4; ++m) { const f32x4 a0 = acc[ai][0][m][0] * oscale, a1 = acc[ai][0][m][1] * oscale, b0 = acc[ai][1][m][0] * oscale, b1 = acc[ai][1][m][1] * oscale;
                    u32x4 w; w.x = pk4_fp8(a0[0], a0[1], a0[2], a0[3]); w.y = pk4_fp8(a1[0], a1[1], a1[2], a1[3]); w.z = pk4_fp8(b0[0], b0[1], b0[2], b0[3]); w.w = pk4_fp8(b1[0], b1[1], b1[2], b1[3]);
                    *(u32x4*)(q8 + (size_t)(row0 + ai * 128 + m * 16) * 512 + pn * 256 + colw) = w; }
            return; }
        if (pn == 2) { base = (bf16_t*)(ws + WS_KVLAT); ld = 256; c0 = 0; }
        else if (pn == 3) { base = (bf16_t*)(ws + WS_KROPE); ld = 64; c0 = 0; ncv = 64; }
        else { const int s = (pn - 4) >> 2; base = (bf16_t*)(ws + WS_RQ + (size_t)s * 32 * MiB); ld = 1024; c0 = ((pn - 4) & 3) * 256; }
#pragma unroll
        for (int ai = 0; ai < 2; ++ai)
#pragma unroll
            for (int m = 0; m < 4; ++m) { bf16_t* rowp = base + (size_t)(row0 + ai * 128 + m * 16) * ld + c0 + colw;
#pragma unroll
                for (int bj = 0; bj < 2; ++bj) { const f32x4 v0 = acc[ai][bj][m][0] * oscale, v1 = acc[ai][bj][m][1] * oscale;
                    u32x4 w; w.x = cvt_pk_bf16(v0[0], v0[1]); w.y = cvt_pk_bf16(v0[2], v0[3]); w.z = cvt_pk_bf16(v1[0], v1[1]); w.w = cvt_pk_bf16(v1[2], v1[3]);
                    if (colw < ncv) *(u32x4*)(rowp + bj * 8) = w; } }
    }
};
struct EpiBf16 {
    static constexpr bool PERM = true;
    bf16_t* O; int ldc; float oscale;
    __device__ __forceinline__ void operator()(const Acc& acc, const pg8::Unit& u, int, LAS unsigned char*, int wr, int wc, int fr, int fq) const {
        asm volatile("" : "+v"(fr), "+v"(fq));
        const int row0 = u.pm * 256 + wr * 64 + fr, col0 = u.pn * 256 + wc * 64 + 16 * fq;
#pragma unroll
        for (int ai = 0; ai < 2; ++ai)
#pragma unroll
            for (int m = 0; m < 4; ++m) { bf16_t* rowp = O + (size_t)(row0 + ai * 128 + m * 16) * ldc + col0;
#pragma unroll
                for (int bj = 0; bj < 2; ++bj) { const f32x4 v0 = acc[ai][bj][m][0] * oscale, v1 = acc[ai][bj][m][1] * oscale;
                    u32x4 w; w.x = cvt_pk_bf16(v0[0], v0[1]); w.y = cvt_pk_bf16(v0[2], v0[3]); w.z = cvt_pk_bf16(v1[0], v1[1]); w.w = cvt_pk_bf16(v1[2], v1[3]);
                    *(u32x4*)(rowp + bj * 8) = w; } }
    }
};
struct EpiOutProj {
    static constexpr bool PERM = true;
    bf16_t* y1; const float* mod; float oscale;
    __device__ __forceinline__ void operator()(const Acc& acc, const pg8::Unit& u, int, LAS unsigned char*, int wr, int wc, int fr, int fq) const {
        asm volatile("" : "+v"(fr), "+v"(fq));
        const int row0 = u.pm * 256 + wr * 64 + fr, col0 = u.pn * 256 + wc * 64 + 16 * fq; const int b = u.pm >> 3;
        f32x4 gv[2][2];
#pragma unroll
        for (int bj = 0; bj < 2; ++bj)
#pragma unroll
            for (int n = 0; n < 2; ++n) gv[bj][n] = *(const f32x4*)(mod + (size_t)b * 12288 + 4096 + col0 + bj * 8 + n * 4) * oscale;
#pragma unroll
        for (int ai = 0; ai < 2; ++ai)
#pragma unroll
            for (int m = 0; m < 4; ++m) { bf16_t* rowp = y1 + (size_t)(row0 + ai * 128 + m * 16) * DM + col0;
#pragma unroll
                for (int bj = 0; bj < 2; ++bj) { const f32x4 v0 = acc[ai][bj][m][0] * gv[bj][0], v1 = acc[ai][bj][m][1] * gv[bj][1];
                    u32x4 w; w.x = cvt_pk_bf16(v0[0], v0[1]); w.y = cvt_pk_bf16(v0[2], v0[3]); w.z = cvt_pk_bf16(v1[0], v1[1]); w.w = cvt_pk_bf16(v1[2], v1[3]);
                    *(u32x4*)(rowp + bj * 8) = w; } }
    }
};
struct EpiRouter {
    static constexpr bool PERM = false;
    float* logit;
    __device__ __forceinline__ void operator()(const Acc& acc, const pg8::Unit& u, int, LAS unsigned char*, int wr, int wc, int fr, int fq) const {
        asm volatile("" : "+v"(fr), "+v"(fq));
        if (wc >= 2) return;
        const int row0 = u.pm * 256 + wr * 64 + fr, col0 = wc * 32 + 4 * fq;
#pragma unroll
        for (int ai = 0; ai < 2; ++ai)
#pragma unroll
            for (int m = 0; m < 4; ++m) { float* rowp = logit + (size_t)u.pn * T * 64 + (size_t)(row0 + ai * 128 + m * 16) * 64 + col0;
#pragma unroll
                for (int n = 0; n < 2; ++n) *(f32x4*)(rowp + n * 16) = acc[ai][0][m][n]; }
    }
};
struct EpiGemm1 {
    static constexpr bool PERM = true;
    unsigned char* act;
    __device__ __forceinline__ void operator()(const Acc& acc, const pg8::Unit& u, int, LAS unsigned char*, int wr, int wc, int fr, int fq) const {
        asm volatile("" : "+v"(fr), "+v"(fq));
        const int r0 = wr * 64 + fr, col0 = u.pn * 128 + wc * 32 + 8 * fq;
#pragma unroll
        for (int ai = 0; ai < 2; ++ai)
#pragma unroll
            for (int m = 0; m < 4; ++m) { const int r = r0 + ai * 128 + m * 16;
                float o[8];
#pragma unroll
                for (int n = 0; n < 2; ++n)
#pragma unroll
                    for (int j = 0; j < 4; ++j) { const float g = acc[ai][0][m][n][j] * (1.0f / 32.0f), up = acc[ai][1][m][n][j] * (1.0f / 32.0f); o[n * 4 + j] = g * __builtin_amdgcn_rcpf(1.0f + __expf(-g)) * up; }
                u32x2 w; w.x = pk4_fp8(o[0], o[1], o[2], o[3]); w.y = pk4_fp8(o[4], o[5], o[6], o[7]);
                if (r < u.rows) *(u32x2*)(act + (size_t)(u.row0 + r) * ED + col0) = w; }
    }
};
struct EpiGemm2 {
    static constexpr bool PERM = true;
    unsigned char* Y;
    __device__ __forceinline__ void operator()(const Acc& acc, const pg8::Unit& u, int, LAS unsigned char*, int wr, int wc, int fr, int fq) const {
        asm volatile("" : "+v"(fr), "+v"(fq));
        const int r0 = wr * 64 + fr, col0 = u.pn * 256 + wc * 64 + 16 * fq; const float s = 1.0f / 16.0f;
#pragma unroll
        for (int ai = 0; ai < 2; ++ai)
#pragma unroll
            for (int m = 0; m < 4; ++m) { const int r = r0 + ai * 128 + m * 16;
                const f32x4 a0 = acc[ai][0][m][0] * s, a1 = acc[ai][0][m][1] * s, b0 = acc[ai][1][m][0] * s, b1 = acc[ai][1][m][1] * s;
                u32x4 w; w.x = pk4_fp8(a0[0], a0[1], a0[2], a0[3]); w.y = pk4_fp8(a1[0], a1[1], a1[2], a1[3]); w.z = pk4_fp8(b0[0], b0[1], b0[2], b0[3]); w.w = pk4_fp8(b1[0], b1[1], b1[2], b1[3]);
                if (r < u.rows) *(u32x4*)(Y + (size_t)(u.row0 + r) * DM + col0) = w; }
    }
};
struct Args { const float* in[26]; float* out; unsigned char* ws; int ph_lo, ph_hi, flags, pad; };
struct Frame {
    LAS unsigned char* lds;
    gu32* ctl;
    int tid, lane, wave, G, bid;
    float* out; unsigned char* ws;
};
#define KARG_PTR(off) (*(const float* const volatile __attribute__((address_space(4)))*)((const __attribute__((address_space(4))) char*)__builtin_amdgcn_kernarg_segment_ptr() + (off)))
#define AIN(i) KARG_PTR(8 * (i))
enum { I_X = 0, I_C, I_POS, I_WADA, I_BADA, I_N1W, I_WIN, I_QLNW, I_WUQ, I_KVLNW, I_WUKV, I_QNW, I_KNW, I_LBF, I_LBB, I_RNW, I_WOUT, I_N2W, I_WRT, I_RBIAS, I_WEG, I_WEU, I_WED, I_WSG, I_WSU, I_WSD };

template <bool F8 = false> __device__ __forceinline__ void conv_item64(const float* W, int N, bf16_t* WT, int ldk, int dst_row0, const float* kscale, int k0, int n0, int lane, float wscale = 1.0f) {
    const int n4 = (lane & 15) * 4, kg = lane >> 4;
    f32x4 v[2][8];
#pragma unroll
    for (int r = 0; r < 2; ++r)
#pragma unroll
        for (int i = 0; i < 8; ++i) v[r][i] = *(const f32x4*)(W + (size_t)(k0 + 32 * r + 8 * kg + i) * N + n0 + n4);
#pragma unroll
    for (int r = 0; r < 2; ++r) { const int kb = k0 + 32 * r + 8 * kg;
        if (kscale) {
#pragma unroll
            for (int i = 0; i < 8; ++i) v[r][i] = v[r][i] * kscale[kb + i]; }
#pragma unroll
        for (int j = 0; j < 4; ++j) {
            if constexpr (F8) { u32x2 o; o.x = pk4_fp8(v[r][0][j] * wscale, v[r][1][j] * wscale, v[r][2][j] * wscale, v[r][3][j] * wscale); o.y = pk4_fp8(v[r][4][j] * wscale, v[r][5][j] * wscale, v[r][6][j] * wscale, v[r][7][j] * wscale);
                *(u32x2*)((unsigned char*)WT + (size_t)(dst_row0 + n4 + j) * ldk + kb) = o; }
            else { u32x4 o; o.x = cvt_pk_bf16(v[r][0][j], v[r][1][j]); o.y = cvt_pk_bf16(v[r][2][j], v[r][3][j]); o.z = cvt_pk_bf16(v[r][4][j], v[r][5][j]); o.w = cvt_pk_bf16(v[r][6][j], v[r][7][j]);
                *(u32x4*)(WT + (size_t)(dst_row0 + n4 + j) * ldk + kb) = o; } } }
}
__device__ __forceinline__ void p0_prologue(Frame& F, const Args& args) {
    if (F.bid < 192) {
        LAS float* cond = (LAS float*)F.lds;
        LAS float* red = (LAS float*)(F.lds + 65536);
        for (int i = F.tid; i < 8 * 2048; i += 512) { const int b = i >> 11, k = i & 2047; const float c = AIN(I_C)[i]; cond[k * 8 + b] = siluf_(c); }
        __syncthreads();
        const int col = F.bid * 64 + F.lane; const float* wp = AIN(I_WADA) + col;
        float acc[8];
#pragma unroll
        for (int b = 0; b < 8; ++b) acc[b] = 0.f;
        const int kb = F.wave * 256;
#pragma unroll 16
        for (int k = 0; k < 256; ++k) { const float wv = wp[(size_t)(kb + k) * 12288]; const f32x4 c0 = *(const LAS f32x4*)(cond + (kb + k) * 8), c1 = *(const LAS f32x4*)(cond + (kb + k) * 8 + 4);
            acc[0] += c0[0] * wv; acc[1] += c0[1] * wv; acc[2] += c0[2] * wv; acc[3] += c0[3] * wv; acc[4] += c1[0] * wv; acc[5] += c1[1] * wv; acc[6] += c1[2] * wv; acc[7] += c1[3] * wv; }
#pragma unroll
        for (int b = 0; b < 8; ++b) red[(F.wave * 8 + b) * 64 + F.lane] = acc[b];
        __syncthreads();
        { const int b = F.wave; float s = AIN(I_BADA)[col];
#pragma unroll
          for (int w = 0; w < 8; ++w) s += red[(w * 8 + b) * 64 + F.lane];
          ((float*)(F.ws + WS_MOD))[b * 12288 + col] = s; }
        __syncthreads();
    }
    { u32x4 z = {0u, 0u, 0u, 0u}; u32x4* p0 = (u32x4*)(F.ws + WS_WIN + (size_t)832 * (INPROJ_FP8 ? 2048 : 4096)); u32x4* p1 = (u32x4*)(F.ws + WS_WRT + (size_t)64 * 4096);
      for (int i = F.bid * 512 + F.tid; i < 49152; i += F.G * 512) { if (i < (INPROJ_FP8 ? 24576 : 49152)) p0[i] = z; p1[i] = z; } }
}
__device__ __forceinline__ unsigned pk4_fp8(float a, float b, float c, float d) { int w = 0; w = __builtin_amdgcn_cvt_pk_fp8_f32(a, b, w, false); w = __builtin_amdgcn_cvt_pk_fp8_f32(c, d, w, true); return (unsigned)w; }
struct CvI { const float* src; unsigned char* dst; const float* kscale; int N, ldk; float scale; int gu, n0l, bf; };
constexpr int CV_NEXP = 3 * 64 * 256 + 3 * 256;
constexpr int CV_IN = 16 * 186, CV_UQ = 4 * 48, CV_UKV = 2 * 64, CV_OUT = 16 * 64, CV_RT = 16 * 2, CV_NSMALL = CV_IN + CV_UQ + CV_UKV + CV_OUT + CV_RT;
__device__ __forceinline__ void cv_decode(int r, CvI& c, unsigned char* ws) {
    unsigned char* WGU8 = ws + WS_WGU; unsigned char* WDN8 = ws + WS_WDN;
    constexpr int I_EX = 64 * 256, I_SH = 256;
    c.kscale = nullptr; c.bf = 0; c.gu = 0; c.n0l = 0;
    if (r >= CV_NEXP) {
        r -= CV_NEXP;
        if (r < CV_IN) { const int kb = r / 186, n0 = (r % 186) * 32, row = n0 + (n0 >= 832 ? 192 : 0); c.src = AIN(I_WIN) + (size_t)(kb * 128) * INC + n0; c.N = INC;
#if INPROJ_FP8
            c.dst = ws + WS_WIN + (size_t)row * 2048 + kb * 128; c.ldk = 2048; c.scale = 32.0f;
#else
            c.dst = ws + WS_WIN + (size_t)row * 4096 + kb * 256; c.ldk = 4096; c.scale = 1.0f; c.bf = 1;
#endif
            return; } r -= CV_IN;
        if (r < CV_UQ) { const int kb = r / 48, n0 = (r % 48) * 32; c.src = AIN(I_WUQ) + (size_t)(kb * 128) * 1536 + n0; c.N = 1536; c.dst = ws + WS_WUQ + (size_t)n0 * 512 + kb * 128; c.ldk = 512; c.scale = 16.0f; c.kscale = AIN(I_QLNW) + kb * 128; return; } r -= CV_UQ;
        if (r < CV_UKV) { const int kb = r / 64, n0 = (r % 64) * 32; c.src = AIN(I_WUKV) + (size_t)(kb * 128) * 2048 + n0; c.N = 2048; c.dst = ws + WS_WUKV + (size_t)n0 * 512 + kb * 256; c.ldk = 512; c.scale = 1.0f; c.bf = 1; c.kscale = AIN(I_KVLNW) + kb * 128; return; } r -= CV_UKV;
        if (r < CV_OUT) { const int kb = r / 64, n0 = (r % 64) * 32; c.src = AIN(I_WOUT) + (size_t)(kb * 128) * 2048 + n0; c.N = 2048; c.dst = ws + WS_WOUT + (size_t)n0 * 2048 + kb * 128; c.ldk = 2048; c.scale = 32.0f; return; } r -= CV_OUT;
        { const int kb = r >> 1, n0 = (r & 1) * 32; c.src = AIN(I_WRT) + (size_t)(kb * 128) * 64 + n0; c.N = 64; c.dst = ws + WS_WRT + (size_t)n0 * 4096 + kb * 256; c.ldk = 4096; c.scale = 1.0f; c.bf = 1; return; }
    }
    int sel, e, q;
    if (r < 3 * I_EX) { sel = r / I_EX; const int rr = r - sel * I_EX; e = rr >> 8; q = rr & 255; } else { const int rr = r - 3 * I_EX; sel = rr / I_SH; q = rr - sel * I_SH; e = 64; }
    if (sel < 2) { const int kb = q >> 4, n0 = (q & 15) * 32; const float* W = (e < 64) ? ((sel == 0 ? AIN(I_WEG) : AIN(I_WEU)) + (size_t)e * 2048 * 512) : (sel == 0 ? AIN(I_WSG) : AIN(I_WSU));
        c.src = W + (size_t)(kb * 128) * 512 + n0; c.N = 512; c.ldk = 2048; c.scale = 32.0f;
        c.dst = WGU8 + (size_t)e * 1024 * 2048 + (size_t)((n0 >> 7) * 256 + sel * 8) * 2048 + kb * 128; c.gu = 1; c.n0l = n0 & 127; }
    else { const int kb = q >> 6, n0 = (q & 63) * 32; const float* W = (e < 64) ? (AIN(I_WED) + (size_t)e * 512 * 2048) : AIN(I_WSD);
        c.src = W + (size_t)(kb * 128) * 2048 + n0; c.N = 2048; c.ldk = 512; c.scale = 16.0f;
        c.dst = WDN8 + (size_t)e * 2048 * 512 + (size_t)n0 * 512 + kb * 128; }
}
__device__ __forceinline__ void cv_load(const CvI& c, int lane, f32x4 (&v)[16]) {
    const float* p = c.src + (size_t)(16 * (lane >> 3)) * c.N + (lane & 7) * 4;
#pragma unroll
    for (int i = 0; i < 16; ++i) v[i] = *(const f32x4*)(p + (size_t)i * c.N);
}
__device__ __forceinline__ void cv_store(const CvI& c, int lane, f32x4 (&v)[16]) {
    const int n4 = (lane & 7) * 4, al = c.n0l + n4, kg = lane >> 3;
    const size_t row = (size_t)(c.gu ? (2 * (al & ~7) + (al & 7)) : n4); const float s = c.scale;
    if (c.kscale) {
#pragma unroll
        for (int i = 0; i < 16; ++i) v[i] = v[i] * c.kscale[16 * kg + i]; }
    if (c.bf) { unsigned char* p = c.dst + row * c.ldk + 32 * kg;
#pragma unroll
        for (int j = 0; j < 4; ++j) { u32x4 o0, o1;
            o0.x = cvt_pk_bf16(v[0][j], v[1][j]); o0.y = cvt_pk_bf16(v[2][j], v[3][j]); o0.z = cvt_pk_bf16(v[4][j], v[5][j]); o0.w = cvt_pk_bf16(v[6][j], v[7][j]);
            o1.x = cvt_pk_bf16(v[8][j], v[9][j]); o1.y = cvt_pk_bf16(v[10][j], v[11][j]); o1.z = cvt_pk_bf16(v[12][j], v[13][j]); o1.w = cvt_pk_bf16(v[14][j], v[15][j]);
            *(u32x4*)(p + (size_t)j * c.ldk) = o0; *(u32x4*)(p + (size_t)j * c.ldk + 16) = o1; }
        return; }
    unsigned char* p = c.dst + row * c.ldk + 16 * kg;
#pragma unroll
    for (int j = 0; j < 4; ++j) { u32x4 o;
        o.x = pk4_fp8(v[0][j] * s, v[1][j] * s, v[2][j] * s, v[3][j] * s); o.y = pk4_fp8(v[4][j] * s, v[5][j] * s, v[6][j] * s, v[7][j] * s);
        o.z = pk4_fp8(v[8][j] * s, v[9][j] * s, v[10][j] * s, v[11][j] * s); o.w = pk4_fp8(v[12][j] * s, v[13][j] * s, v[14][j] * s, v[15][j] * s);
        *(u32x4*)(p + (size_t)j * c.ldk) = o; }
}
__device__ __forceinline__ void convert_range(Frame& F, const Args& args, int w, int nw, int lo, int hi) {
    CvI A, B; f32x4 va[16], vb[16];
    int it = lo + w; if (it >= hi) return;
    cv_decode(it, A, F.ws); cv_load(A, F.lane, va);
    for (;;) {
        const int itn = it + nw; const bool hasn = itn < hi;
        if (hasn) { cv_decode(itn, B, F.ws); cv_load(B, F.lane, vb); }
        cv_store(A, F.lane, va);
        if (!hasn) break;
        it = itn + nw; const bool has2 = it < hi;
        if (has2) { cv_decode(it, A, F.ws); cv_load(A, F.lane, va); }
        cv_store(B, F.lane, vb);
        if (!has2) break;
    }
}
__device__ __forceinline__ void convert_experts(Frame& F, const Args& args, int b0, int nblk) {
    convert_range(F, args, (F.bid - b0) * NWAVES + F.wave, nblk * NWAVES, 0, CV_NEXP + CV_NSMALL);
}

template <bool ADD, bool OUT16, bool OUT8, bool SUM16 = false> __device__ __forceinline__ void rms_mod_rows(Frame& F, const Args& args, const float* src, const bf16_t* add, const float* nw, int sh_off, int sc_off, bf16_t* dst, unsigned char* dst8) {
    const int gw = F.bid * NWAVES + F.wave, NGW = F.G * NWAVES;
    const float* mod = (const float*)(F.ws + WS_MOD);
    for (int g0 = gw * 8; g0 < T; g0 += NGW * 8) {
        const int b = g0 >> 11;
        f32x4 a[8], sh[8];
#pragma unroll
        for (int j = 0; j < 8; ++j) { const int c = j * 256 + F.lane * 4; const f32x4 w = *(const f32x4*)(nw + c), s = *(const f32x4*)(mod + b * 12288 + sc_off + c); a[j] = w * (s + 1.0f); sh[j] = *(const f32x4*)(mod + b * 12288 + sh_off + c); }
        f32x4 nx[8]; u32x2 na[8];
        { const f32x4* xr = (const f32x4*)(src + (size_t)g0 * DM) + F.lane; const u32x2* ar = (const u32x2*)(add + (size_t)g0 * DM) + F.lane;
#pragma unroll
          for (int j = 0; j < 8; ++j) { nx[j] = xr[64 * j]; if (ADD) na[j] = ar[64 * j]; } }
        for (int m = g0; m < g0 + 8; ++m) {
            f32x4 v[8]; float s = 0.f;
#pragma unroll
            for (int j = 0; j < 8; ++j) { v[j] = nx[j]; if (ADD) { v[j].x += bf_lo(na[j].x); v[j].y += bf_hi(na[j].x); v[j].z += bf_lo(na[j].y); v[j].w += bf_hi(na[j].y); } }
            if (m + 1 < g0 + 8) { const f32x4* xr = (const f32x4*)(src + (size_t)(m + 1) * DM) + F.lane; const u32x2* ar = (const u32x2*)(add + (size_t)(m + 1) * DM) + F.lane;
#pragma unroll
                for (int j = 0; j < 8; ++j) { nx[j] = xr[64 * j]; if (ADD) na[j] = ar[64 * j]; } }
#pragma unroll
            for (int j = 0; j < 8; ++j) s += (v[j].x * v[j].x + v[j].y * v[j].y) + (v[j].z * v[j].z + v[j].w * v[j].w);
            if (SUM16) { u32x2* sr = (u32x2*)(const_cast<bf16_t*>(add) + (size_t)m * DM) + F.lane;
#pragma unroll
                for (int j = 0; j < 8; ++j) { u32x2 w; w.x = cvt_pk_bf16(v[j].x, v[j].y); w.y = cvt_pk_bf16(v[j].z, v[j].w); sr[64 * j] = w; } }
            const float rstd = __builtin_amdgcn_rsqf(wave_sum(s) * (1.f / DM) + EPS);
            u32x2* o8 = (u32x2*)(dst + (size_t)m * DM) + F.lane; unsigned* o4 = (unsigned*)(dst8 + (size_t)m * DM) + F.lane;
#pragma unroll
            for (int j = 0; j < 8; ++j) { const f32x4 y = v[j] * rstd * a[j] + sh[j];
                if (OUT16) { u32x2 w; w.x = cvt_pk_bf16(y.x, y.y); w.y = cvt_pk_bf16(y.z, y.w); o8[64 * j] = w; }
                if (OUT8) o4[64 * j] = pk4_fp8(y.x, y.y, y.z, y.w); }
        }
    }
}

__device__ __forceinline__ void add_fp8x8(const u32x2 w, float (&acc)[8]) {
    f32x2 p;
    p = __builtin_amdgcn_cvt_pk_f32_fp8((int)w.x, false); acc[0] += p.x; acc[1] += p.y; p = __builtin_amdgcn_cvt_pk_f32_fp8((int)w.x, true); acc[2] += p.x; acc[3] += p.y;
    p = __builtin_amdgcn_cvt_pk_f32_fp8((int)w.y, false); acc[4] += p.x; acc[5] += p.y; p = __builtin_amdgcn_cvt_pk_f32_fp8((int)w.y, true); acc[6] += p.x; acc[7] += p.y;
}
__device__ __forceinline__ void unpack8(const u32x4 w, float (&f)[8]) { f[0] = bf_lo(w.x); f[1] = bf_hi(w.x); f[2] = bf_lo(w.y); f[3] = bf_hi(w.y); f[4] = bf_lo(w.z); f[5] = bf_hi(w.z); f[6] = bf_lo(w.w); f[7] = bf_hi(w.w); }
__device__ __forceinline__ u32x4 pack8(const float* f) { u32x4 w; w.x = cvt_pk_bf16(f[0], f[1]); w.y = cvt_pk_bf16(f[2], f[3]); w.z = cvt_pk_bf16(f[4], f[5]); w.w = cvt_pk_bf16(f[6], f[7]); return w; }
__device__ __forceinline__ void ld8f(const LAS float* p, float (&f)[8]) { const f32x4 a = *(const LAS f32x4*)p, b = *(const LAS f32x4*)(p + 4); f[0] = a[0]; f[1] = a[1]; f[2] = a[2]; f[3] = a[3]; f[4] = b[0]; f[5] = b[1]; f[6] = b[2]; f[7] = b[3]; }
__device__ __forceinline__ u32x2 pack8_fp8(const float* f) { u32x2 w; w.x = pk4_fp8(f[0], f[1], f[2], f[3]); w.y = pk4_fp8(f[4], f[5], f[6], f[7]); return w; }
__device__ __forceinline__ void head_norm_rope_store(const LAS float* scr, const LAS float* cs, const LAS float* sn, const LAS float* nw, float oscale, unsigned char* dst, int lane) {
    const int head = lane >> 3, part = lane & 7; const LAS float* hv = scr + head * 192;
    float x0[8], x1[8], x2[8], xp[8];
    ld8f(hv + 8 * part, x0); ld8f(hv + 64 + 8 * part, x1); ld8f(hv + 128 + 8 * part, x2);
    const bool first = part < 4; const int pofs = first ? (160 + 8 * part) : (96 + 8 * part);
    ld8f(hv + pofs, xp);
    float ss = 0.f;
#pragma unroll
    for (int e = 0; e < 8; ++e) ss += x0[e] * x0[e] + x1[e] * x1[e] + x2[e] * x2[e];
    ss += __shfl_xor(ss, 1); ss += __shfl_xor(ss, 2); ss += __shfl_xor(ss, 4);
    const float r = __builtin_amdgcn_rsqf(ss * (1.f / 192.f) + EPS) * oscale;
    float w[8], o[8];
    ld8f(nw + 8 * part, w);
#pragma unroll
    for (int e = 0; e < 8; ++e) o[e] = x0[e] * w[e] * r;
    *(u32x2*)(dst + 8 * part) = pack8_fp8(o);
    ld8f(nw + 64 + 8 * part, w);
#pragma unroll
    for (int e = 0; e < 8; ++e) o[e] = x1[e] * w[e] * r;
    *(u32x2*)(dst + 64 + 8 * part) = pack8_fp8(o);
    float wp[8], c[8], sv[8];
    ld8f(nw + 128 + 8 * part, w); ld8f(nw + pofs, wp); ld8f(cs + 8 * (part & 3), c); ld8f(sn + 8 * (part & 3), sv);
#pragma unroll
    for (int e = 0; e < 8; ++e) { const float own = x2[e] * w[e], oth = xp[e] * wp[e];
        o[e] = (first ? (own * c[e] - oth * sv[e]) : (oth * sv[e] + own * c[e])) * r; }
    *(u32x2*)(dst + 128 + 8 * part) = pack8_fp8(o);
}
__device__ __forceinline__ void finalize_qkv(Frame& F, const Args& args) {
    LAS float* scr = (LAS float*)(F.lds + F.wave * 12288); LAS float* cs = scr + 2048; LAS float* sn = cs + 32;
    LAS float* qnw = (LAS float*)(F.lds + 8 * 12288); LAS float* knw = qnw + 192;
    if (F.tid < 192) qnw[F.tid] = AIN(I_QNW)[F.tid]; else if (F.tid < 384) knw[F.tid - 192] = AIN(I_KNW)[F.tid - 192];
    __syncthreads();
    const int gw = F.bid * NWAVES + F.wave, NGW = F.G * NWAVES, lane = F.lane;
    const bf16_t* QLAT = (const bf16_t*)(F.ws + WS_QLAT); const bf16_t* KVLAT = (const bf16_t*)(F.ws + WS_KVLAT); const bf16_t* KROPE = (const bf16_t*)(F.ws + WS_KROPE);
    const bf16_t* QRAW = (const bf16_t*)(F.ws + WS_QRAW); const bf16_t* KVRAW = (const bf16_t*)(F.ws + WS_KVRAW);
    unsigned char* Q = F.ws + WS_Q; unsigned char* K = F.ws + WS_K; bf16_t* V = (bf16_t*)(F.ws + WS_V);
    const float qscale = 0.07216878364870322f * 1.4426950408889634f;
    const float inv = __builtin_amdgcn_exp2f(-(float)(2 * (lane & 31)) * (13.287712379549449f / 64.f));
    u32x4 n_kvl, n_qr[3], n_kvr[4], n_kr; u32x2 n_ql8; int n_pos;
#define FQ_LOAD(tok) do { n_ql8 = *(const u32x2*)((const unsigned char*)QLAT + (size_t)(tok) * 512 + lane * 8); n_kvl = *(const u32x4*)(KVLAT + (size_t)(tok) * 256 + (lane & 31) * 8); n_kr = *(const u32x4*)(KROPE + (size_t)(tok) * 64 + (lane & 7) * 8); \
        n_pos = ((const int*)AIN(I_POS))[tok]; _Pragma("unroll") for (int j = 0; j < 3; ++j) n_qr[j] = *(const u32x4*)(QRAW + (size_t)(tok) * 1536 + (j * 64 + lane) * 8); \
        _Pragma("unroll") for (int j = 0; j < 4; ++j) n_kvr[j] = *(const u32x4*)(KVRAW + (size_t)(tok) * 2048 + (j * 64 + lane) * 8); } while (0)
    if (gw < T) FQ_LOAD(gw);
    for (int tok = gw; tok < T; tok += NGW) {
        const u32x4 c_kvl = n_kvl, c_kr = n_kr; const u32x2 c_ql8 = n_ql8; const int pos = n_pos; u32x4 c_qr[3], c_kvr[4];
#pragma unroll
        for (int j = 0; j < 3; ++j) c_qr[j] = n_qr[j];
#pragma unroll
        for (int j = 0; j < 4; ++j) c_kvr[j] = n_kvr[j];
        if (tok + NGW < T) FQ_LOAD(tok + NGW);
        const int b = tok >> 11, s = tok & 2047;
        if (lane < 32) { const float ang = (float)pos * inv;
            const float kq = rintf(ang * 0.15915494309189535f); float rr = fmaf(-kq, 6.2831854820251465f, ang); rr = fmaf(-kq, -1.7484555e-7f, rr);
            const float rev = rr * 0.15915494309189535f;
            cs[lane] = __builtin_amdgcn_cosf(rev); sn[lane] = __builtin_amdgcn_sinf(rev); }
        float f[8];
#pragma unroll
        for (int e = 0; e < 8; ++e) f[e] = 0.f;
        add_fp8x8(c_ql8, f); float sq = 0.f;
#pragma unroll
        for (int e = 0; e < 8; ++e) sq += f[e] * f[e];
        const float rstd_q = __builtin_amdgcn_rsqf(wave_sum(sq) * (1.f / 512.f) + EPS);
        float sk = 0.f;
        if (lane < 32) { unpack8(c_kvl, f);
#pragma unroll
            for (int e = 0; e < 8; ++e) sk += f[e] * f[e]; }
        const float rstd_kv = __builtin_amdgcn_rsqf(wave_sum(sk) * (1.f / 256.f) + EPS);
#pragma unroll
        for (int j = 0; j < 3; ++j) { const int ci = j * 64 + lane; unpack8(c_qr[j], f);
            *(LAS f32x4*)(scr + ci * 8) = (f32x4){f[0], f[1], f[2], f[3]} * rstd_q; *(LAS f32x4*)(scr + ci * 8 + 4) = (f32x4){f[4], f[5], f[6], f[7]} * rstd_q; }
        LDS_WAIT(); asm volatile("" ::: "memory");
        head_norm_rope_store(scr, cs, sn, qnw, qscale, Q + ((size_t)(b * NH + (lane >> 3)) * SEQ + s) * DQK, lane);
        LDS_WAIT(); asm volatile("" ::: "memory");
#pragma unroll
        for (int j = 0; j < 4; ++j) { const int ci = j * 64 + lane; const int head = ci >> 5, within = (ci & 31) * 8; unpack8(c_kvr[j], f);
#pragma unroll
            for (int e = 0; e < 8; ++e) f[e] *= rstd_kv;
            if (within < 128) { *(LAS f32x4*)(scr + head * 192 + within) = (f32x4){f[0], f[1], f[2], f[3]}; *(LAS f32x4*)(scr + head * 192 + within + 4) = (f32x4){f[4], f[5], f[6], f[7]}; }
            else *(u32x4*)(V + ((size_t)(b * NH + head) * SEQ + s) * DV + (within - 128)) = pack8(f); }
        if (lane < 8) { unpack8(c_kr, f);
#pragma unroll
            for (int h = 0; h < 8; ++h) { *(LAS f32x4*)(scr + h * 192 + 128 + lane * 8) = (f32x4){f[0], f[1], f[2], f[3]}; *(LAS f32x4*)(scr + h * 192 + 128 + lane * 8 + 4) = (f32x4){f[4], f[5], f[6], f[7]}; } }
        LDS_WAIT(); asm volatile("" ::: "memory");
        head_norm_rope_store(scr, cs, sn, knw, 1.0f, K + ((size_t)(b * NH + (lane >> 3)) * SEQ + s) * DQK, lane);
        LDS_WAIT(); asm volatile("" ::: "memory");
    }
#undef FQ_LOAD
}

__device__ __forceinline__ void rec_chunk32(Frame& F, const Args& args, int tok0) {
    const int lane = F.lane;
    const bf16_t* OFp = (const bf16_t*)(F.ws + WS_OF); const bf16_t* OBp = (const bf16_t*)(F.ws + WS_OB); const bf16_t* RG = (const bf16_t*)(F.ws + WS_RG); unsigned char* CAT = F.ws + WS_CAT;
    u32x4 n[4][6];
#pragma unroll
    for (int i = 0; i < 4; ++i) { const size_t o = (size_t)(tok0 + F.wave * 4 + i) * 1024 + lane * 16;
        n[i][0] = *(const u32x4*)(OFp + o); n[i][1] = *(const u32x4*)(OFp + o + 8); n[i][2] = *(const u32x4*)(OBp + o); n[i][3] = *(const u32x4*)(OBp + o + 8); n[i][4] = *(const u32x4*)(RG + o); n[i][5] = *(const u32x4*)(RG + o + 8); }
    float nw[16];
#pragma unroll
    for (int e = 0; e < 16; ++e) nw[e] = AIN(I_RNW)[(lane & 7) * 16 + e];
#pragma unroll
    for (int i = 0; i < 4; ++i) {
        float a[16], bb[16], g[16];
        unpack8(n[i][0], *(float(*)[8])a); unpack8(n[i][1], *(float(*)[8])(a + 8));
        unpack8(n[i][2], *(float(*)[8])bb); unpack8(n[i][3], *(float(*)[8])(bb + 8));
        unpack8(n[i][4], *(float(*)[8])g); unpack8(n[i][5], *(float(*)[8])(g + 8));
        float ss = 0.f;
#pragma unroll
        for (int e = 0; e < 16; ++e) { a[e] += bb[e]; ss += a[e] * a[e]; }
        ss += __shfl_xor(ss, 1); ss += __shfl_xor(ss, 2); ss += __shfl_xor(ss, 4);
        const float r = __builtin_amdgcn_rsqf(ss * (1.f / 128.f) + EPS);
#pragma unroll
        for (int e = 0; e < 16; ++e) a[e] = a[e] * r * nw[e] * siluf_(g[e]);
        u32x4 w8; w8.x = pk4_fp8(a[0], a[1], a[2], a[3]); w8.y = pk4_fp8(a[4], a[5], a[6], a[7]); w8.z = pk4_fp8(a[8], a[9], a[10], a[11]); w8.w = pk4_fp8(a[12], a[13], a[14], a[15]);
        *(u32x4*)(CAT + (size_t)(tok0 + F.wave * 4 + i) * 2048 + 1024 + lane * 16) = w8;
    }
}

__device__ __forceinline__ float wave_max_dpp(float v) {
#define WM_STEP(ctrl) v = fmaxf(v, __int_as_float(__builtin_amdgcn_update_dpp(__float_as_int(v), __float_as_int(v), ctrl, 0xF, 0xF, false)))
    WM_STEP(0xB1); WM_STEP(0x4E); WM_STEP(0x141); WM_STEP(0x140);
#undef WM_STEP
    const float r0 = __int_as_float(__builtin_amdgcn_readlane(__float_as_int(v), 0)), r1 = __int_as_float(__builtin_amdgcn_readlane(__float_as_int(v), 16));
    const float r2 = __int_as_float(__builtin_amdgcn_readlane(__float_as_int(v), 32)), r3 = __int_as_float(__builtin_amdgcn_readlane(__float_as_int(v), 48));
    return fmaxf(fmaxf(r0, r1), fmaxf(r2, r3));
}
__device__ __forceinline__ float wave_sum_dpp(float v) {
#define WS_STEP(ctrl) v += __int_as_float(__builtin_amdgcn_update_dpp(0, __float_as_int(v), ctrl, 0xF, 0xF, false))
    WS_STEP(0xB1); WS_STEP(0x4E); WS_STEP(0x141); WS_STEP(0x140);
#undef WS_STEP
    const float r0 = __int_as_float(__builtin_amdgcn_readlane(__float_as_int(v), 0)), r1 = __int_as_float(__builtin_amdgcn_readlane(__float_as_int(v), 16));
    const float r2 = __int_as_float(__builtin_amdgcn_readlane(__float_as_int(v), 32)), r3 = __int_as_float(__builtin_amdgcn_readlane(__float_as_int(v), 48));
    return (r0 + r1) + (r2 + r3);
}
__device__ __forceinline__ float grp8_max_dpp(float v) {
#define WM_STEP(ctrl) v = fmaxf(v, __int_as_float(__builtin_amdgcn_update_dpp(__float_as_int(v), __float_as_int(v), ctrl, 0xF, 0xF, false)))
    WM_STEP(0xB1); WM_STEP(0x4E); WM_STEP(0x141);
#undef WM_STEP
    return v;
}
__device__ __forceinline__ void route_topk(Frame& F, const Args& args) {
    const int gw = F.bid * NWAVES + F.wave, NGW = F.G * NWAVES, lane = F.lane;
    const float* logit = (const float*)(F.ws + WS_LOGIT); int* elist = (int*)(F.ws + WS_ELIST); int* slot_ep = (int*)(F.ws + WS_SLOTEP); float* slot_w = (float*)(F.ws + WS_SLOTW);
    const float bias = AIN(I_RBIAS)[lane]; const int g = lane >> 3;
    const float NEG = -__builtin_inff();
    LAS unsigned* hist = (LAS unsigned*)F.lds; LAS unsigned* hbase = hist + 64;
    for (int tok0 = gw; tok0 < T; tok0 += 8 * NGW) {
        if (F.tid < 64) hist[F.tid] = 0u;
        __syncthreads();
        float wv[8]; int erv[8]; unsigned lpv[8]; float lg[8];
#pragma unroll
        for (int i = 0; i < 8; ++i) { const int tok = tok0 + i * NGW; const size_t li = (size_t)(tok < T ? tok : 0) * 64 + lane;
            lg[i] = (logit[li] + logit[li + (size_t)T * 64]) + (logit[li + (size_t)2 * T * 64] + logit[li + (size_t)3 * T * 64]); }
#pragma unroll 1
        for (int i = 0; i < 8; ++i) { const int tok = tok0 + i * NGW; float w_ = 0.f; int er_ = -1; unsigned lp_ = 0u;
          float lgi = lg[0];
#pragma unroll
          for (int q = 1; q < 8; ++q) lgi = (q == i) ? lg[q] : lgi;
          if (tok < T) {
            float sc = sigmoidf_(lgi); sc = (sc == sc) ? sc : 0.5f;
            const float sel = sc + bias;
            const float m1 = grp8_max_dpp(sel);
            const unsigned long long bal = __ballot(sel == m1) & (0xFFull << (8 * g)); const int first = __builtin_ctzll(bal);
            const float m2 = grp8_max_dpp((lane == first) ? NEG : sel);
            const float gs = m1 + m2; int grank = 0;
#pragma unroll
            for (int j = 0; j < 8; ++j) { const float v = __int_as_float(__builtin_amdgcn_readlane(__float_as_int(gs), 8 * j)); grank += (v > gs || (v == gs && j < g)) ? 1 : 0; }
            const bool chosen = grank < TOPG; float rem = chosen ? sel : NEG; int er = TOPK;
#pragma unroll
            for (int k = 0; k < TOPK; ++k) { const float m = wave_max_dpp(rem); const int pick = __builtin_ctzll(__ballot(rem == m)); if (lane == pick) { er = k; rem = NEG; } }
            const bool selected = er < TOPK;
            const float sumw = wave_sum_dpp(selected ? sc : 0.f); w_ = sc / sumw * ROUTED_SCALE;
            if (selected) { er_ = er; lp_ = __hip_atomic_fetch_add(hist + lane, 1u, __ATOMIC_RELAXED, __HIP_MEMORY_SCOPE_WORKGROUP); }
            if (lane == 0) elist[(size_t)64 * 16384 + tok] = tok * 8;
          }
#pragma unroll
          for (int q = 0; q < 8; ++q) if (q == i) { wv[q] = w_; erv[q] = er_; lpv[q] = lp_; }
        }
        __syncthreads();
        if (F.tid < 64) { const unsigned c = hist[F.tid]; hbase[F.tid] = c ? __hip_atomic_fetch_add((unsigned*)(F.ctl + CW_CNT + 64 * F.tid), c, RLX_AGENT) : 0u; }
        __syncthreads();
        const unsigned base = hbase[lane];
#pragma unroll
        for (int i = 0; i < 8; ++i) { const int tok = tok0 + i * NGW;
            if (erv[i] >= 0) { const unsigned pos = base + lpv[i]; elist[(size_t)lane * 16384 + pos] = tok * 8 + erv[i]; slot_ep[tok * 8 + erv[i]] = (lane << 16) | (int)pos; slot_w[tok * 8 + erv[i]] = wv[i]; } }
        __syncthreads();
    }
}

__device__ __forceinline__ void moe_combine(Frame& F, const Args& args) {
    const int gw = F.bid * NWAVES + F.wave, NGW = F.G * NWAVES, lane = F.lane;
    const unsigned char* Y = (const unsigned char*)(F.ws + WS_Y); const float* mod = (const float*)(F.ws + WS_MOD);
    const int* slot_ep = (const int*)(F.ws + WS_SLOTEP); const float* slot_w = (const float*)(F.ws + WS_SLOTW); const bf16_t* Y1 = (const bf16_t*)(F.ws + WS_Y1);
    const LAS int* ro = (const LAS int*)(F.lds + GTAB_OFF) + 132;
    const int sh0 = ro[64];
    for (int tok = gw; tok < T; tok += NGW) {
        const int b = tok >> 11;
        int myrow = 0; float myw = 0.f;
        if (lane < 8) { const int ep = slot_ep[tok * 8 + lane]; myrow = ro[ep >> 16] + (ep & 0xffff); myw = slot_w[tok * 8 + lane]; }
        int rows[8]; float wk[8];
#pragma unroll
        for (int k = 0; k < 8; ++k) { rows[k] = __shfl(myrow, k); wk[k] = __shfl(myw, k); }
#pragma unroll
        for (int j = 0; j < 4; ++j) { const int col = j * 512 + lane * 8; float acc[8];
#pragma unroll
            for (int e = 0; e < 8; ++e) acc[e] = 0.f;
            u32x2 yv[9];
            yv[8] = *(const u32x2*)(Y + (size_t)(sh0 + tok) * DM + col);
#pragma unroll
            for (int k = 0; k < 8; ++k) yv[k] = *(const u32x2*)(Y + (size_t)rows[k] * DM + col);
#pragma unroll
            for (int k = 0; k < 8; ++k) { float t8[8];
#pragma unroll
                for (int e = 0; e < 8; ++e) t8[e] = 0.f;
                add_fp8x8(yv[k], t8);
#pragma unroll
                for (int e = 0; e < 8; ++e) acc[e] += wk[k] * t8[e]; }
            add_fp8x8(yv[8], acc);
            float* op = F.out + (size_t)tok * DM + col; const float* gp = mod + b * 12288 + 10240 + col;
            const u32x4 yw = *(const u32x4*)(Y1 + (size_t)tok * DM + col);
            const f32x4 g0 = *(const f32x4*)gp, g1 = *(const f32x4*)(gp + 4);
            *(f32x4*)op = (f32x4){bf_lo(yw.x), bf_hi(yw.x), bf_lo(yw.y), bf_hi(yw.y)} + g0 * (f32x4){acc[0], acc[1], acc[2], acc[3]};
            *(f32x4*)(op + 4) = (f32x4){bf_lo(yw.z), bf_hi(yw.z), bf_lo(yw.w), bf_hi(yw.w)} + g1 * (f32x4){acc[4], acc[5], acc[6], acc[7]}; }
    }
}
namespace att {
constexpr int KT_BYTES = 64 * 192, VT_BYTES = 64 * 256;
constexpr int L_K = 0, L_V = 2 * KT_BYTES, L_WS = L_V + 2 * VT_BYTES, L_END = L_WS + 8 * 256;
constexpr float THR = 8.f * 1.4426950408889634f;
#define ATT_SBAR() __builtin_amdgcn_sched_barrier(0)
__device__ __forceinline__ int crow(int r, int hi) { return (r & 3) + 8 * (r >> 2) + 4 * hi; }
__device__ __forceinline__ int kswz(int row, int chunk) { return row * 192 + (((chunk & ~3) | ((chunk & 3) ^ ((row >> 2) & 3))) << 4); }
typedef int v8i_a __attribute__((ext_vector_type(8)));
__device__ __forceinline__ void partialSM(f32x16& p0, f32x16& p1, float& m_reg, float& mn, float& alpha) {
    float pmax = fmaxf(p0[0], p1[0]);
#pragma unroll
    for (int r = 1; r < 16; r += 2) pmax = __builtin_fmaxf(__builtin_fmaxf(pmax, p0[r]), p0[r + 1 < 16 ? r + 1 : r]);
#pragma unroll
    for (int r = 1; r < 16; r += 2) pmax = __builtin_fmaxf(__builtin_fmaxf(pmax, p1[r]), p1[r + 1 < 16 ? r + 1 : r]);
    { auto rr = __builtin_amdgcn_permlane32_swap(__float_as_uint(pmax), __float_as_uint(pmax), false, false); pmax = fmaxf(__uint_as_float(rr[0]), __uint_as_float(rr[1])); }
    if (__builtin_expect(__all(pmax <= THR), 1)) { mn = 0.f; alpha = 1.f;
#pragma unroll
        for (int r = 0; r < 16; ++r) p0[r] = __builtin_amdgcn_exp2f(p0[r]);
    } else { mn = fmaxf(pmax, 0.f); alpha = __builtin_amdgcn_exp2f(-mn); m_reg += mn;
#pragma unroll
        for (int r = 0; r < 16; ++r) p0[r] = __builtin_amdgcn_exp2f(p0[r] - mn);
    }
}
__device__ __forceinline__ void finishSM(f32x16& p0, f32x16& p1, float mn, float alpha, float& l_reg, bf16x8& pa0, bf16x8& pa1, bf16x8& pa2, bf16x8& pa3) {
    if (__builtin_expect(__all(mn == 0.f), 1)) {
#pragma unroll
        for (int r = 0; r < 16; ++r) p1[r] = __builtin_amdgcn_exp2f(p1[r]);
    } else {
#pragma unroll
        for (int r = 0; r < 16; ++r) p1[r] = __builtin_amdgcn_exp2f(p1[r] - mn);
    }
    float ps = 0;
#pragma unroll
    for (int r = 0; r < 16; ++r) ps += p0[r];
#pragma unroll
    for (int r = 0; r < 16; ++r) ps += p1[r];
    { auto rr = __builtin_amdgcn_permlane32_swap(__float_as_uint(ps), __float_as_uint(ps), false, false); ps = __uint_as_float(rr[0]) + __uint_as_float(rr[1]); }
    l_reg = l_reg * alpha + ps;
#define ATT_PK4(P, BASE, OUT) do { unsigned a0 = cvt_pk_bf16(P[BASE + 0], P[BASE + 1]), a1 = cvt_pk_bf16(P[BASE + 2], P[BASE + 3]);   \
    unsigned b0 = cvt_pk_bf16(P[BASE + 4], P[BASE + 5]), b1 = cvt_pk_bf16(P[BASE + 6], P[BASE + 7]);                              \
    auto r0 = __builtin_amdgcn_permlane32_swap(a0, b0, false, false); auto r1 = __builtin_amdgcn_permlane32_swap(a1, b1, false, false); \
    u32x4 w = {r0[0], r1[0], r0[1], r1[1]}; OUT = *reinterpret_cast<bf16x8*>(&w); } while (0)
    ATT_PK4(p0, 0, pa0); ATT_PK4(p0, 8, pa1); ATT_PK4(p1, 0, pa2); ATT_PK4(p1, 8, pa3);
#undef ATT_PK4
}
__device__ __forceinline__ v8i_a ld32(const char* p0, const char* p1) { const u32x4 lo = *reinterpret_cast<const u32x4*>(p0), hi = *reinterpret_cast<const u32x4*>(p1); return (v8i_a){(int)lo.x, (int)lo.y, (int)lo.z, (int)lo.w, (int)hi.x, (int)hi.y, (int)hi.z, (int)hi.w}; }
__device__ __forceinline__ void qkt(f32x16& p0, f32x16& p1, const char* Ks, const v8i_a* qr, int r32, int hi, float m_reg) {
    const float c0 = -m_reg;
#pragma unroll
    for (int r = 0; r < 16; ++r) { p0[r] = c0; p1[r] = c0; }
#pragma unroll
    for (int s = 0; s < 3; ++s) { const int ch = 4 * s + 2 * hi;
        const v8i_a a0 = ld32(Ks + kswz(r32, ch), Ks + kswz(r32, ch + 1)), a1 = ld32(Ks + kswz(32 + r32, ch), Ks + kswz(32 + r32, ch + 1));
        p0 = __builtin_amdgcn_mfma_scale_f32_32x32x64_f8f6f4(a0, qr[s], p0, 0, 0, 0, 0, 0, 0);
        p1 = __builtin_amdgcn_mfma_scale_f32_32x32x64_f8f6f4(a1, qr[s], p1, 0, 0, 0, 0, 0, 0); }
}
__device__ __forceinline__ int v_rd_base(int lane) { return ((lane & 3) << 3) | (((lane >> 2) & 3) << 6) | (((lane >> 4) & 1) << 5) | (((lane >> 5) & 1) << 8); }
constexpr int v_rd_off(int d0, int ks, int half) { return d0 * 512 + ks * 4096 + half * 2048; }
template <int OFF> __device__ __forceinline__ s16x4 tr_read(int vb) { s16x4 r; asm volatile("ds_read_b64_tr_b16 %0, %1 offset:%2" : "=&v"(r) : "v"(vb), "i"(OFF) : "memory"); return r; }
template <int D0> __device__ __forceinline__ void pv_one(f32x16& od, int vb, bf16x8 pa0, bf16x8 pa1, bf16x8 pa2, bf16x8 pa3) {
    const s16x4 l0 = tr_read<v_rd_off(D0, 0, 0)>(vb), h0 = tr_read<v_rd_off(D0, 0, 1)>(vb), l1 = tr_read<v_rd_off(D0, 1, 0)>(vb), h1 = tr_read<v_rd_off(D0, 1, 1)>(vb);
    const s16x4 l2 = tr_read<v_rd_off(D0, 2, 0)>(vb), h2 = tr_read<v_rd_off(D0, 2, 1)>(vb), l3 = tr_read<v_rd_off(D0, 3, 0)>(vb), h3 = tr_read<v_rd_off(D0, 3, 1)>(vb);
    asm volatile("s_waitcnt lgkmcnt(0)" ::: "memory"); ATT_SBAR();
#define ATT_PK(L, H) (bf16x8){L[0], L[1], L[2], L[3], H[0], H[1], H[2], H[3]}
    od = __builtin_amdgcn_mfma_f32_32x32x16_bf16(pa0, ATT_PK(l0, h0), od, 0, 0, 0);
    od = __builtin_amdgcn_mfma_f32_32x32x16_bf16(pa1, ATT_PK(l1, h1), od, 0, 0, 0);
    od = __builtin_amdgcn_mfma_f32_32x32x16_bf16(pa2, ATT_PK(l2, h2), od, 0, 0, 0);
    od = __builtin_amdgcn_mfma_f32_32x32x16_bf16(pa3, ATT_PK(l3, h3), od, 0, 0, 0);
#undef ATT_PK
}
__device__ __forceinline__ void pv_d0(f32x16* o, int vb, bf16x8 pa0, bf16x8 pa1, bf16x8 pa2, bf16x8 pa3) {
    pv_one<0>(o[0], vb, pa0, pa1, pa2, pa3); pv_one<1>(o[1], vb, pa0, pa1, pa2, pa3); pv_one<2>(o[2], vb, pa0, pa1, pa2, pa3); pv_one<3>(o[3], vb, pa0, pa1, pa2, pa3);
}
__device__ __forceinline__ void attn_unit(const unsigned char* __restrict__ Qb, const unsigned char* __restrict__ Kh, const bf16_t* __restrict__ Vh, bf16_t* __restrict__ Ob, int ldo, char* lds) {
    int tid = threadIdx.x; asm volatile("" : "+v"(tid));
    const int wid = __builtin_amdgcn_readfirstlane(tid >> 6), lane = tid & 63, r32 = lane & 31, hi = lane >> 5;
    char* K_lds = lds + L_K; char* V_lds = lds + L_V;
    float* ws = (float*)(lds + L_WS) + wid * 64; float* li_l = ws; float* al_l = ws + 32;
    float m_reg = 0.f, l_reg = 0; f32x16 o[4] = {}; v8i_a qr[3];
    const char* Qw = (const char*)Qb + (size_t)(wid * 32 + r32) * DQK + hi * 32;
#pragma unroll
    for (int s = 0; s < 3; ++s) qr[s] = ld32(Qw + s * 64, Qw + s * 64 + 16);
    const int vb0 = (int)(uintptr_t)(LAS char*)(V_lds) + v_rd_base(lane);
#define ATT_DMA_K(t, b) do { const char* _g = (const char*)Kh + (size_t)(t) * KT_BYTES; int _ln = lane; asm volatile("" : "+v"(_ln)); _Pragma("unroll") for (int _i = 0; _i < 2; ++_i) { \
        if (_i * 8 + wid < 12) { const int _p = (_i * 8 + wid) * 64 + _ln, _row = _p / 12, _cp = _p % 12, _c = (_cp & ~3) | ((_cp & 3) ^ ((_row >> 2) & 3)); \
        __builtin_amdgcn_global_load_lds((const unsigned*)(_g + (unsigned)(_row * 192 + _c * 16)), (LAS unsigned*)(K_lds + (b) * KT_BYTES + (_i * 8 + wid) * 1024), 16, 0, 0); } } } while (0)
#define ATT_DMA_V(t, b) do { const char* _g = (const char*)Vh + (size_t)(t) * VT_BYTES; int _ln = lane; asm volatile("" : "+v"(_ln)); _Pragma("unroll") for (int _i = 0; _i < 2; ++_i) { \
        const int _off = ((_i * 8 + wid) * 64 + _ln) * 16, _sub = _off >> 9, _within = _off & 511, _kk = (_sub >> 2) * 8 + (_within >> 6), _k = (_kk & ~0xC) | ((_kk & 4) << 1) | ((_kk & 8) >> 1), _c = (_sub & 3) * 32 + ((_within & 63) >> 1); \
        __builtin_amdgcn_global_load_lds((const unsigned*)(_g + (unsigned)(_k * 256 + _c * 2)), (LAS unsigned*)(V_lds + (b) * VT_BYTES + (_i * 8 + wid) * 1024), 16, 0, 0); } } while (0)
#define ATT_WB() do { asm volatile("s_waitcnt vmcnt(0)" ::: "memory"); __builtin_amdgcn_s_barrier(); asm volatile("" ::: "memory"); } while (0)
#define ATT_RESC(a) do { if (__any((a) < 1.f)) { if (hi == 0) al_l[r32] = (a); asm volatile("s_waitcnt lgkmcnt(0)" ::: "memory"); \
    _Pragma("unroll") for (int d = 0; d < 4; ++d) _Pragma("unroll") for (int r = 0; r < 16; ++r) o[d][r] *= al_l[crow(r, hi)]; } } while (0)
    f32x16 pA0, pA1, pB0, pB1; float mnA, mnB, alA, alB; bf16x8 pa0, pa1, pa2, pa3; constexpr int NT = SEQ / 64;
    ATT_DMA_K(0, 0); ATT_WB();
    ATT_DMA_K(1, 1); ATT_DMA_V(0, 0);
    qkt(pA0, pA1, K_lds, qr, r32, hi, m_reg); partialSM(pA0, pA1, m_reg, mnA, alA);
    ATT_WB();
    for (int j = 1; j + 1 < NT; j += 2) {
        ATT_DMA_K(j + 1, 0); ATT_DMA_V(j, 1);
        ATT_SBAR(); qkt(pB0, pB1, K_lds + KT_BYTES, qr, r32, hi, m_reg);
        finishSM(pA0, pA1, mnA, alA, l_reg, pa0, pa1, pa2, pa3); ATT_SBAR();
        pv_d0(o, vb0, pa0, pa1, pa2, pa3); partialSM(pB0, pB1, m_reg, mnB, alB);
        ATT_RESC(alB); ATT_WB();
        ATT_DMA_K(j + 2, 1); ATT_DMA_V(j + 1, 0);
        ATT_SBAR(); qkt(pA0, pA1, K_lds, qr, r32, hi, m_reg);
        finishSM(pB0, pB1, mnB, alB, l_reg, pa0, pa1, pa2, pa3); ATT_SBAR();
        pv_d0(o, vb0 + VT_BYTES, pa0, pa1, pa2, pa3); partialSM(pA0, pA1, m_reg, mnA, alA);
        ATT_RESC(alA); ATT_WB();
    }
    ATT_DMA_V(NT - 1, 1);
    ATT_SBAR(); qkt(pB0, pB1, K_lds + KT_BYTES, qr, r32, hi, m_reg);
    finishSM(pA0, pA1, mnA, alA, l_reg, pa0, pa1, pa2, pa3); ATT_SBAR();
    pv_d0(o, vb0, pa0, pa1, pa2, pa3); partialSM(pB0, pB1, m_reg, mnB, alB);
    ATT_RESC(alB); ATT_WB();
    finishSM(pB0, pB1, mnB, alB, l_reg, pa0, pa1, pa2, pa3); ATT_SBAR();
    pv_d0(o, vb0 + VT_BYTES, pa0, pa1, pa2, pa3);
    if (hi == 0) li_l[r32] = l_reg; asm volatile("s_waitcnt lgkmcnt(0)" ::: "memory");
    float rli[16];
#pragma unroll
    for (int r = 0; r < 16; ++r) rli[r] = __builtin_amdgcn_rcpf(li_l[crow(r, hi)]);
    __builtin_amdgcn_s_barrier(); asm volatile("" ::: "memory");
    unsigned char* st = (unsigned char*)(lds + wid * 4096);
#pragma unroll
    for (int r = 0; r < 16; ++r) { const int orow = crow(r, hi);
#pragma unroll
        for (int d0 = 0; d0 < 4; ++d0) { const float v = o[d0][r] * rli[r]; st[orow * 128 + d0 * 32 + r32] = (unsigned char)(__builtin_amdgcn_cvt_pk_fp8_f32(v, v, 0, false) & 0xff); } }
    asm volatile("s_waitcnt lgkmcnt(0)" ::: "memory");
#pragma unroll
    for (int i = 0; i < 4; ++i) { const int q = i * 64 + lane, row = q >> 3, c = q & 7;
        *(u32x4*)((unsigned char*)Ob + (size_t)(wid * 32 + row) * ldo + c * 16) = *(const u32x4*)(st + row * 128 + c * 16); }
    asm volatile("s_waitcnt lgkmcnt(0)" ::: "memory"); __builtin_amdgcn_s_barrier(); asm volatile("" ::: "memory");
#undef ATT_DMA_K
#undef ATT_DMA_V
#undef ATT_WB
#undef ATT_RESC
}
}

namespace hg {
constexpr int O_QT = 0, O_KT = 16384, O_QD = 32768, O_KTT = 49152, O_VT = 65536, O_AM = 81920, O_ST = 90112, O_PART = 122880, O_SL = 126976, O_SP = 127488;
__device__ __forceinline__ int sw256(int row, int cb) { return row * 256 + (cb ^ ((row & 15) << 4)); }
__device__ __forceinline__ int sw128(int row, int cb) { return row * 128 + (cb ^ (((row >> 1) & 7) << 4)); }
__device__ __forceinline__ bf16x8 ld8(LAS unsigned char* p) { return *(const LAS bf16x8*)p; }
__device__ __forceinline__ void hgrn_chain(LAS unsigned char* lds, unsigned char* ws, const float* lb_fwd, const float* lb_bwd, int chain) {
    const int b = chain >> 4, h = (chain >> 1) & 7, dir = chain & 1;
    const bf16_t* RQ = (const bf16_t*)(ws + WS_RQ); const bf16_t* RZ = (const bf16_t*)(ws + (dir ? WS_RFB : WS_RFF)); const bf16_t* RI = (const bf16_t*)(ws + WS_RI);
    bf16_t* O = (bf16_t*)(ws + (dir ? WS_OB : WS_OF));
    int tid = threadIdx.x; asm volatile("" : "+v"(tid));
    const int wid = __builtin_amdgcn_readfirstlane(tid >> 6), lane = tid & 63, r32 = lane & 31, hi = lane >> 5;
    const int k0 = 2 * lane;
    const float* lbp = dir ? lb_bwd : lb_fwd;
    const float lb0 = sigmoidf_(lbp[h * 128 + k0] - lbp[1024 + h * 128 + k0]), lb1 = sigmoidf_(lbp[h * 128 + k0 + 1] - lbp[1024 + h * 128 + k0 + 1]);
    LAS float* PART = (LAS float*)(lds + O_PART); LAS float* SL = (LAS float*)(lds + O_SL); LAS float* SP = (LAS float*)(lds + O_SP);
    for (int i = tid; i < 32768 / 16; i += 512) ((LAS u32x4*)(lds + O_ST))[i] = (u32x4){0u, 0u, 0u, 0u};
    f32x16 S0 = {}, S1 = {};
    unsigned zc[8], qc[8]; u32x4 va, vb;
    const size_t colbase = (size_t)h * 128;
    const int ipair = tid >> 4, c16 = tid & 15;
#define HG_TT(c, i) (dir ? (2047 - (64 * (c) + (i))) : (64 * (c) + (i)))
#define HG_LOAD(c) do { _Pragma("unroll") for (int s = 0; s < 8; ++s) { const size_t off = ((size_t)(b * 2048 + HG_TT(c, 8 * wid + s))) * 1024 + colbase + k0; zc[s] = *(const unsigned*)(RZ + off); qc[s] = *(const unsigned*)(RQ + off); } \
        va = *(const u32x4*)(RI + ((size_t)(b * 2048 + HG_TT(c, 2 * ipair))) * 1024 + colbase + c16 * 8); vb = *(const u32x4*)(RI + ((size_t)(b * 2048 + HG_TT(c, 2 * ipair + 1))) * 1024 + colbase + c16 * 8); } while (0)
    HG_LOAD(0);
    for (int c = 0; c < 32; ++c) {
        float Lp0[8], Lp1[8], kk0[8], kk1[8]; float run0 = 1.f, run1 = 1.f;
#pragma unroll
        for (int s = 0; s < 8; ++s) { const float f0 = lb0 + (1.0f - lb0) * sigmoidf_(bf_lo(zc[s])), f1 = lb1 + (1.0f - lb1) * sigmoidf_(bf_hi(zc[s]));
            run0 *= f0; run1 *= f1; Lp0[s] = run0; Lp1[s] = run1; kk0[s] = 1.0f - f0; kk1[s] = 1.0f - f1; }
        *(LAS f32x2*)(PART + wid * 128 + k0) = (f32x2){run0, run1};
        __syncthreads();
        { float pre0 = 1.f, pre1 = 1.f, p31_0 = 1.f, p31_1 = 1.f, pl0 = 1.f, pl1 = 1.f;
#pragma unroll
          for (int q = 0; q < 8; ++q) { const f32x2 t = *(const LAS f32x2*)(PART + q * 128 + k0); if (q < wid) { pre0 *= t.x; pre1 *= t.y; } if (q < 4) { p31_0 *= t.x; p31_1 *= t.y; } pl0 *= t.x; pl1 *= t.y; }
          const float r31_0 = __builtin_amdgcn_rcpf(fmaxf(p31_0, 1e-37f)), r31_1 = __builtin_amdgcn_rcpf(fmaxf(p31_1, 1e-37f));
          float kt0[8], kt1[8];
#pragma unroll
          for (int s = 0; s < 8; ++s) { const int i = 8 * wid + s; const float P0 = pre0 * Lp0[s], P1 = pre1 * Lp1[s];
              const float rP0 = __builtin_amdgcn_rcpf(fmaxf(P0, 1e-37f)), rP1 = __builtin_amdgcn_rcpf(fmaxf(P1, 1e-37f));
              const float q0 = bf_lo(qc[s]), q1 = bf_hi(qc[s]);
              const float qd0 = q0 * P0, qd1 = q1 * P1; kt0[s] = kk0[s] * (p31_0 * rP0); kt1[s] = kk1[s] * (p31_1 * rP1);
              const int ad = sw256(i, 4 * lane);
              *(LAS unsigned*)(lds + O_QT + ad) = cvt_pk_bf16(qd0 * r31_0, qd1 * r31_1); *(LAS unsigned*)(lds + O_KT + ad) = cvt_pk_bf16(kt0[s], kt1[s]); *(LAS unsigned*)(lds + O_QD + ad) = cvt_pk_bf16(qd0, qd1); }
          u32x4 w0, w1; w0.x = cvt_pk_bf16(kt0[0], kt0[1]); w0.y = cvt_pk_bf16(kt0[2], kt0[3]); w0.z = cvt_pk_bf16(kt0[4], kt0[5]); w0.w = cvt_pk_bf16(kt0[6], kt0[7]);
          w1.x = cvt_pk_bf16(kt1[0], kt1[1]); w1.y = cvt_pk_bf16(kt1[2], kt1[3]); w1.z = cvt_pk_bf16(kt1[4], kt1[5]); w1.w = cvt_pk_bf16(kt1[6], kt1[7]);
          *(LAS u32x4*)(lds + O_KTT + sw128(k0, 16 * wid)) = w0; *(LAS u32x4*)(lds + O_KTT + sw128(k0 + 1, 16 * wid)) = w1;
          if (wid == 0) { *(LAS f32x2*)(SL + k0) = (f32x2){pl0, pl1}; *(LAS f32x2*)(SP + k0) = (f32x2){pl0 * r31_0, pl1 * r31_1}; } }
        { const unsigned a4[4] = {va.x, va.y, va.z, va.w}, b4[4] = {vb.x, vb.y, vb.z, vb.w};
#pragma unroll
          for (int e = 0; e < 8; ++e) { const unsigned lo = (e & 1) ? (a4[e >> 1] >> 16) : (a4[e >> 1] & 0xffffu), hi16 = (e & 1) ? (b4[e >> 1] & 0xffff0000u) : (b4[e >> 1] << 16);
              *(LAS unsigned*)(lds + O_VT + sw128(c16 * 8 + e, 4 * ipair)) = lo | hi16; } }
        if (c + 1 < 32) HG_LOAD(c + 1);
        __syncthreads();
        if (wid < 4) { const int si = wid >> 1, ti = wid & 1; f32x16 a = {};
#pragma unroll
            for (int ks = 0; ks < 8; ++ks) { const int cb = (16 * ks + 8 * hi) * 2;
                a = __builtin_amdgcn_mfma_f32_32x32x16_bf16(ld8(lds + O_KT + sw256(32 * si + r32, cb)), ld8(lds + O_QT + sw256(32 * ti + r32, cb)), a, 0, 0, 0); }
            const int t = 32 * ti + r32;
#pragma unroll
            for (int q = 0; q < 4; ++q) { const int s0 = 32 * si + 8 * q + 4 * hi; float v[4];
#pragma unroll
                for (int j = 0; j < 4; ++j) v[j] = (s0 + j <= t) ? a[4 * q + j] : 0.f;
                u32x2 w; w.x = cvt_pk_bf16(v[0], v[1]); w.y = cvt_pk_bf16(v[2], v[3]); *(LAS u32x2*)(lds + O_AM + sw128(t, s0 * 2)) = w; } }
        const int vi = wid >> 1, ii = wid & 1; f32x16 oacc = {};
#pragma unroll
        for (int ks = 0; ks < 8; ++ks) { const int cb = (16 * ks + 8 * hi) * 2;
            oacc = __builtin_amdgcn_mfma_f32_32x32x16_bf16(ld8(lds + O_ST + sw256(32 * vi + r32, cb)), ld8(lds + O_QD + sw256(32 * ii + r32, cb)), oacc, 0, 0, 0); }
        const int ki = wid >> 1;
        float sl[16], sp[16];
#pragma unroll
        for (int r = 0; r < 16; ++r) { const int kr = 32 * ki + (r & 3) + 8 * (r >> 2) + 4 * hi; sl[r] = SL[kr]; sp[r] = SP[kr]; }
        { f32x16 P = {}; const int v2 = 2 * (wid & 1);
#pragma unroll
          for (int ks = 0; ks < 4; ++ks) { const int cb = (16 * ks + 8 * hi) * 2;
              P = __builtin_amdgcn_mfma_f32_32x32x16_bf16(ld8(lds + O_KTT + sw128(32 * ki + r32, cb)), ld8(lds + O_VT + sw128(32 * v2 + r32, cb)), P, 0, 0, 0); }
#pragma unroll
          for (int r = 0; r < 16; ++r) S0[r] = sl[r] * S0[r] + sp[r] * P[r]; }
        { f32x16 P = {}; const int v2 = 2 * (wid & 1) + 1;
#pragma unroll
          for (int ks = 0; ks < 4; ++ks) { const int cb = (16 * ks + 8 * hi) * 2;
              P = __builtin_amdgcn_mfma_f32_32x32x16_bf16(ld8(lds + O_KTT + sw128(32 * ki + r32, cb)), ld8(lds + O_VT + sw128(32 * v2 + r32, cb)), P, 0, 0, 0); }
#pragma unroll
          for (int r = 0; r < 16; ++r) S1[r] = sl[r] * S1[r] + sp[r] * P[r]; }
        __syncthreads();
#pragma unroll
        for (int ks = 0; ks < 4; ++ks) { const int cb = (16 * ks + 8 * hi) * 2;
            oacc = __builtin_amdgcn_mfma_f32_32x32x16_bf16(ld8(lds + O_VT + sw128(32 * vi + r32, cb)), ld8(lds + O_AM + sw128(32 * ii + r32, cb)), oacc, 0, 0, 0); }
        { const int i = 32 * ii + r32; const int tt = dir ? (2047 - (64 * c + i)) : (64 * c + i); bf16_t* orow = O + ((size_t)(b * 2048 + tt)) * 1024 + colbase + 32 * vi + 4 * hi;
#pragma unroll
          for (int q = 0; q < 4; ++q) { u32x2 w; w.x = cvt_pk_bf16(oacc[4 * q], oacc[4 * q + 1]); w.y = cvt_pk_bf16(oacc[4 * q + 2], oacc[4 * q + 3]); *(u32x2*)(orow + 8 * q) = w; } }
#pragma unroll
        for (int q = 0; q < 4; ++q) { const int k0 = 32 * ki + 8 * q + 4 * hi; const int v0 = 32 * (2 * (wid & 1)) + r32, v1 = v0 + 32;
            u32x2 w; w.x = cvt_pk_bf16(S0[4 * q], S0[4 * q + 1]); w.y = cvt_pk_bf16(S0[4 * q + 2], S0[4 * q + 3]); *(LAS u32x2*)(lds + O_ST + sw256(v0, k0 * 2)) = w;
            w.x = cvt_pk_bf16(S1[4 * q], S1[4 * q + 1]); w.y = cvt_pk_bf16(S1[4 * q + 2], S1[4 * q + 3]); *(LAS u32x2*)(lds + O_ST + sw256(v1, k0 * 2)) = w; }
#ifdef HG_EXTRA_BAR
        __syncthreads();
#endif
    }
    __syncthreads();
#undef HG_LOAD
#undef HG_TT
}
}
constexpr int N_PHASES = 14;

__device__ __forceinline__ void build_group_tab(Frame& F) {
    LAS int* tab = (LAS int*)(F.lds + GTAB_OFF);
    if (F.wave == 0) {
        const int c = (int)__hip_atomic_load((unsigned*)(F.ctl + CW_CNT + 64 * F.lane), RLX_AGENT);
        int ti = (c + 255) >> 8, ci = c;
#pragma unroll
        for (int o = 1; o < 64; o <<= 1) { const int a = __shfl_up(ti, o), b2 = __shfl_up(ci, o); if (F.lane >= o) { ti += a; ci += b2; } }
        tab[F.lane + 1] = ti; tab[66 + F.lane] = c; tab[132 + F.lane] = ci - c;
        if (F.lane == 63) { tab[65] = ti + T / 256; tab[66 + 64] = T; tab[132 + 64] = ci; }
        if (F.lane == 0) tab[0] = 0;
    }
    __syncthreads();
}

__global__ void __launch_bounds__(NWAVES * 64, 2) hymba_fwd(Args args) {
    extern __shared__ __attribute__((aligned(16))) unsigned char lds_raw[];
    Frame F;
    F.lds = (LAS unsigned char*)lds_raw;
    F.tid = threadIdx.x; F.lane = F.tid & 63; F.wave = __builtin_amdgcn_readfirstlane(F.tid >> 6);
    F.G = gridDim.x; F.bid = blockIdx.x;
    F.ws = args.ws; F.ctl = (gu32*)(args.ws + WS_CTL); F.out = args.out;
    for (int u = F.tid; u < (LDS_BYTES - LDSCTL_OFF) / 4; u += NWAVES * 64) ((LAS unsigned*)(F.lds + LDSCTL_OFF))[u] = 0u;
    __syncthreads();
    volatile LAS unsigned* MISC = (volatile LAS unsigned*)(F.lds + MISC_OFF);
    const int lo = args.ph_lo, hi = args.ph_hi;
    const bool fused = (hi - lo) > 1;
    XcdBarrier bar; bar.bar = (unsigned*)(F.ctl + CW_BAR); bar.x = 0; bar.st = nullptr;
    if (fused) bar = xcd_barrier_post((unsigned*)(F.ctl + CW_BAR), MISC + 8);
#ifndef PH_MASK
#define PH_MASK 0x3fff
#endif
#define IN(k) (((PH_MASK >> (k)) & 1) && lo <= (k) && (k) < hi)
#define SEAM(k) do { if (IN(k) && IN((k) + 1)) xcd_barrier(bar); { int _t = threadIdx.x; asm volatile("" : "+v"(_t)); F.tid = _t; F.lane = _t & 63; F.wave = __builtin_amdgcn_readfirstlane(_t >> 6); } } while (0)
    unsigned char* ws = args.ws;

#ifndef NCONV_BLOCKS
#define NCONV_BLOCKS 0
#endif
    if (IN(0)) { p0_prologue(F, args); convert_range(F, args, F.bid * NWAVES + F.wave, F.G * NWAVES, CV_NEXP, CV_NEXP + CV_NSMALL); } SEAM(0);
#if INPROJ_FP8
    if (IN(1)) { rms_mod_rows<false, false, true>(F, args, AIN(I_X), nullptr, AIN(I_N1W), 0, 2048, nullptr, ws + WS_H); } SEAM(1);
#else
    if (IN(1)) { rms_mod_rows<false, true, false>(F, args, AIN(I_X), nullptr, AIN(I_N1W), 0, 2048, (bf16_t*)(ws + WS_H), nullptr); } SEAM(1);
#endif
#if INPROJ_FP8
    if (IN(2)) { pg8::DenseOrder S; S.init(ws + WS_H, 2048, ws + WS_WIN, 2048, T, INCP, F.G, F.bid); EpiInProj E{ws, 1.0f / 32.0f}; pg8::gemm_phase<EpiInProj, pg8::DenseOrder, true, true, true>(F.lds, 2048, 2048, S, E); } SEAM(2);
#else
    if (IN(2)) { pg8::DenseOrder S; S.init(ws + WS_H, 4096, ws + WS_WIN, 4096, T, INCP, F.G, F.bid); EpiInProj E{ws, 1.0f}; pg8::gemm_phase<EpiInProj, pg8::DenseOrder, true, false>(F.lds, 4096, 4096, S, E); } SEAM(2);
#endif
    if (IN(3)) {
        { pg8::DenseOrder S; S.init(ws + WS_QLAT, 512, ws + WS_WUQ, 512, T, 1536, F.G, F.bid); EpiBf16 E{(bf16_t*)(ws + WS_QRAW), 1536, 1.0f / 16.0f}; pg8::gemm_phase<EpiBf16, pg8::DenseOrder, true, true, true>(F.lds, 512, 512, S, E); }
        { pg8::DenseOrder S; S.init(ws + WS_KVLAT, 512, ws + WS_WUKV, 512, T, 2048, F.G, F.bid); EpiBf16 E{(bf16_t*)(ws + WS_KVRAW), 2048, 1.0f}; pg8::gemm_phase<EpiBf16, pg8::DenseOrder>(F.lds, 512, 512, S, E); }
    } SEAM(3);
    if (IN(4)) { finalize_qkv(F, args); } SEAM(4);
    if (IN(5)) {
#ifndef NO_HGRN
        if (!(args.flags & 1)) for (int ch = F.bid; ch < 128; ch += F.G) { hg::hgrn_chain(F.lds, ws, AIN(I_LBF), AIN(I_LBB), ch);
            asm volatile("s_waitcnt vmcnt(0)" ::: "memory"); __syncthreads();
            if (threadIdx.x == 0) { __builtin_amdgcn_fence(__ATOMIC_RELEASE, "agent"); asm volatile("s_waitcnt vmcnt(0)" ::: "memory"); (void)__hip_atomic_fetch_add((unsigned*)(F.ctl + CW_HGDONE), 1u, RLX_AGENT); } }
#endif
#ifndef NCV
#define NCV 96
#endif
#define CV_CHUNKS ((CV_NEXP + 63) / 64)
#define CV_PULL() do { for (;;) { if (F.tid == 0) MISC[0] = __hip_atomic_fetch_add((unsigned*)(F.ctl + CW_CVQ), 1u, RLX_AGENT); \
            __syncthreads(); const unsigned c = MISC[0]; __syncthreads(); if (c >= (unsigned)CV_CHUNKS) break; \
            const int lo = (int)c * 64; convert_range(F, args, F.wave, NWAVES, lo, (lo + 64 < CV_NEXP) ? lo + 64 : CV_NEXP); } } while (0)
        if (!(args.flags & 1) && F.bid >= F.G - NCV) CV_PULL();
#ifndef NO_ATTN
        if (!(args.flags & 2)) { const unsigned x0 = xb_xcc_id() & 7u; unsigned k = 0;
          for (;;) {
            if (F.tid == 0) { unsigned u = 0xffffffffu;
                for (; k < 8u; ++k) { const unsigned y = (x0 + k) & 7u; const unsigned v = __hip_atomic_fetch_add((unsigned*)(F.ctl + CW_QUEUE + 16 * y), 1u, RLX_AGENT); if (v < 64u) { u = ((y + 8u * (v >> 3)) << 3) | (v & 7u); break; } }
                MISC[0] = u; }
            __syncthreads(); const unsigned u = MISC[0]; __syncthreads();
            if (u >= 512u) break;
            const int bh = (int)(u >> 3), qb = (int)(u & 7), b = bh >> 3, h = bh & 7;
            att::attn_unit(ws + WS_Q + ((size_t)bh * SEQ + qb * 256) * DQK, ws + WS_K + (size_t)bh * SEQ * DQK, (const bf16_t*)(ws + WS_V) + (size_t)bh * SEQ * DV,
                           (bf16_t*)(ws + WS_CAT + ((size_t)(b * SEQ + qb * 256)) * 2048 + h * 128), 2048, (char*)lds_raw);
          } }
#endif
        if (!(args.flags & 1)) { { int t = threadIdx.x; asm volatile("" : "+v"(t)); F.tid = t; F.lane = t & 63; F.wave = __builtin_amdgcn_readfirstlane(t >> 6); } CV_PULL(); }
        { int t = threadIdx.x; asm volatile("" : "+v"(t)); F.tid = t; F.lane = t & 63; F.wave = __builtin_amdgcn_readfirstlane(t >> 6); }
        if (F.tid == 0) { unsigned sp = 0; while (__hip_atomic_load((unsigned*)(F.ctl + CW_HGDONE), __ATOMIC_RELAXED, __HIP_MEMORY_SCOPE_AGENT) < 128u) { __builtin_amdgcn_s_sleep(8); if (++sp > (1u << 22)) break; }
            __builtin_amdgcn_fence(__ATOMIC_ACQUIRE, "agent"); }
        __syncthreads();
        for (;;) {
            if (F.tid == 0) MISC[0] = __hip_atomic_fetch_add((unsigned*)(F.ctl + CW_RECQ), 1u, RLX_AGENT);
            __syncthreads(); const unsigned c = MISC[0]; __syncthreads();
            if (c >= (unsigned)(T / 32)) break;
            rec_chunk32(F, args, (int)c * 32);
        }
    } SEAM(5);
    if (IN(7)) { pg8::DenseOrder S; S.init(ws + WS_CAT, 2048, ws + WS_WOUT, 2048, T, 2048, F.G, F.bid); EpiOutProj E{(bf16_t*)(ws + WS_Y1), (const float*)(ws + WS_MOD), 1.0f / 32.0f}; pg8::gemm_phase<EpiOutProj, pg8::DenseOrder, true, true, true>(F.lds, 2048, 2048, S, E); } SEAM(7);
    if (IN(8)) { rms_mod_rows<true, true, true, true>(F, args, AIN(I_X), (const bf16_t*)(ws + WS_Y1), AIN(I_N2W), 6144, 8192, (bf16_t*)(ws + WS_H), ws + WS_H8); } SEAM(8);
    if (IN(9)) { pg8::SplitKOrder S; S.A = (const char*)(ws + WS_H); S.Bt = (const char*)(ws + WS_WRT); S.lda2 = 4096; S.KS2 = 1024; S.nM = 64; S.nS = 4; S.nwg = 256; S.G = F.G; S.c = F.bid;
        EpiRouter E{(float*)(ws + WS_LOGIT)}; pg8::gemm_phase<EpiRouter, pg8::SplitKOrder>(F.lds, 1024, 4096, S, E); } SEAM(9);
    if (IN(10)) { route_topk(F, args); } SEAM(10);
    if (IN(11)) {
        build_group_tab(F); const LAS int* tab = (const LAS int*)(F.lds + GTAB_OFF);
        pg8::GroupedOrder<true, false, 2> S; S.A = (const char*)(ws + WS_H8); S.lda2 = 2048; S.Bt = (const char*)(ws + WS_WGU); S.bexp = (size_t)1024 * 2048; S.K2 = 2048;
        S.elist = (const int*)(ws + WS_ELIST); S.ewt = nullptr; S.tab = tab; S.tpl = tab[F.lane + 1]; S.total = __builtin_amdgcn_readfirstlane(tab[65]) << 2; S.G = F.G; S.c = F.bid;
        EpiGemm1 E{ws + WS_ACT}; pg8::gemm_phase<EpiGemm1, pg8::GroupedOrder<true, false, 2>, false, true, true>(F.lds, 2048, 2048, S, E);
    } SEAM(11);
    if (IN(12)) {
        build_group_tab(F); const LAS int* tab = (const LAS int*)(F.lds + GTAB_OFF);
        pg8::GroupedOrder<false, false, 3> S; S.A = (const char*)(ws + WS_ACT); S.lda2 = 512; S.Bt = (const char*)(ws + WS_WDN); S.bexp = (size_t)2048 * 512; S.K2 = 512;
        S.elist = nullptr; S.ewt = nullptr; S.tab = tab; S.tpl = tab[F.lane + 1]; S.total = __builtin_amdgcn_readfirstlane(tab[65]) << 3; S.G = F.G; S.c = F.bid;
        EpiGemm2 E{ws + WS_Y}; pg8::gemm_phase<EpiGemm2, pg8::GroupedOrder<false, false, 3>, false, true, true>(F.lds, 512, 512, S, E);
    } SEAM(12);
    if (IN(13)) { build_group_tab(F); moe_combine(F, args); }
#undef IN
#undef SEAM
}

#ifndef MK_FUSED
#define MK_FUSED 1
#endif
extern "C" void kernel_launch(void* const* d_in, const int* in_sizes, int n_in, void* d_out, int out_size, void* d_ws, size_t ws_size, hipStream_t stream) {
    static int grid = 0;
    if (grid == 0) {
        if (n_in != 26 || in_sizes[0] != T * DM || out_size != T * DM || ws_size < WS_END) { fprintf(stderr, "kernel_launch: unexpected shapes (n_in %d, in0 %d, out %d, ws %zu < %zu)\n", n_in, n_in > 0 ? in_sizes[0] : -1, out_size, ws_size, (size_t)WS_END); grid = -1; return; }
        int dev = 0, cus = 0, per_cu = 0;
        if (hipGetDevice(&dev) != hipSuccess || hipDeviceGetAttribute(&cus, hipDeviceAttributeMultiprocessorCount, dev) != hipSuccess) { grid = -1; return; }
        if (hipFuncSetAttribute((const void*)hymba_fwd, hipFuncAttributeMaxDynamicSharedMemorySize, LDS_BYTES) != hipSuccess) { fprintf(stderr, "kernel_launch: hipFuncSetAttribute failed\n"); grid = -1; return; }
        if (hipOccupancyMaxActiveBlocksPerMultiprocessor(&per_cu, (const void*)hymba_fwd, NWAVES * 64, LDS_BYTES) != hipSuccess || per_cu < 1) fprintf(stderr, "kernel_launch: occupancy query reports %d\n", per_cu);
        (void)hipGetLastError();
        grid = cus;
    }
    if (grid < 0) return;
    if (hipMemsetAsync((char*)d_ws + WS_CTL, 0, CTL_ZERO_BYTES, stream) != hipSuccess) return;
    Args a{};
    for (int i = 0; i < 26; ++i) a.in[i] = (const float*)d_in[i];
    a.out = (float*)d_out; a.ws = (unsigned char*)d_ws;
#if MK_FUSED
    a.ph_lo = 0; a.ph_hi = N_PHASES;
    hipLaunchKernelGGL(hymba_fwd, dim3(grid), dim3(NWAVES * 64), LDS_BYTES, stream, a);
#else
#ifndef PROBE_FLAGS
#define PROBE_FLAGS 0
#endif
#ifndef PROBE_REP_MASK
#define PROBE_REP_MASK 0
#endif
#ifndef PROBE_REPS
#define PROBE_REPS 1
#endif
    for (int p = 0; p < N_PHASES; ++p) { a.ph_lo = p; a.ph_hi = p + 1; hipLaunchKernelGGL(hymba_fwd, dim3(grid), dim3(NWAVES * 64), LDS_BYTES, stream, a);
        if ((PROBE_REP_MASK >> p) & 1) for (int rep = 0; rep < PROBE_REPS; ++rep) { if (p == 5) (void)hipMemsetAsync((char*)d_ws + WS_CTL + CW_QUEUE * 4, 0, 512, stream); if (p == 10) (void)hipMemsetAsync((char*)d_ws + WS_CTL + CW_CNT * 4, 0, 65 * 64 * 4, stream); a.flags = PROBE_FLAGS; hipLaunchKernelGGL(hymba_fwd, dim3(grid), dim3(NWAVES * 64), LDS_BYTES, stream, a); a.flags = 0; } }
#endif
    const hipError_t le = hipPeekAtLastError();
    if (le != hipSuccess) fprintf(stderr, "kernel_launch: launch failed: %s\n", hipGetErrorName(le));
}
```
